# Optimizing an MI355X kernel written in HIP

```python
import math
import jax
import jax.numpy as jnp
from jax import lax
import numpy as np

D_MODEL = 1024
BATCH = 8
SEQ = 2048
DEPTH = 4
DEC_BATCH = 128
DEC_SEQ = 8
PAST_LEN = 16384
PAGE_SIZE = 128

N_META = 16
N_MIXERS = 3
CHUNK = 64
ALPHA = (2 * DEPTH) ** 0.25
BETA = (8 * DEPTH) ** -0.25
LN_EPS = 1e-5
D_FF = ((8 * D_MODEL // 3 + 127) // 128) * 128
HG_EXPAND = 128
HG_HEADS = D_MODEL // HG_EXPAND
HG_DK = HG_EXPAND
HG_DV = D_MODEL // HG_HEADS
RET_HEADS = 4
RET_DK = D_MODEL // RET_HEADS
RET_DV = 2 * D_MODEL // RET_HEADS
ROPE_BASE = 10000.0
M_DI = 2 * D_MODEL
M_HEADDIM = 64
M_HEADS = M_DI // M_HEADDIM
M_GROUPS = 8
M_DSTATE = 128
M_CONV = 4
M_CONV_DIM = M_DI + 2 * M_GROUPS * M_DSTATE
N_HG_LAYERS = len(range(0, DEPTH, N_MIXERS))
N_RET_LAYERS = len(range(1, DEPTH, N_MIXERS))
N_SSM_LAYERS = len(range(2, DEPTH, N_MIXERS))

kernel_name = 'hybrid_hgrn2_retnet_mamba2_macaron_deepnorm_step'

F32 = jnp.float32


def layer_norm(x, g, b):
    xf = x.astype(F32)
    mu = jnp.mean(xf, axis=-1, keepdims=True)
    var = jnp.mean(jnp.square(xf - mu), axis=-1, keepdims=True)
    return ((xf - mu) * lax.rsqrt(var + LN_EPS) * g.astype(F32) + b.astype(F32)).astype(x.dtype)


def head_layer_norm(o, g):
    mu = jnp.mean(o, axis=-1, keepdims=True)
    var = jnp.mean(jnp.square(o - mu), axis=-1, keepdims=True)
    return (o - mu) * lax.rsqrt(var + LN_EPS) * g.astype(F32).reshape(o.shape[2:])


def head_rms_norm(o, g):
    ms = jnp.mean(jnp.square(o), axis=-1, keepdims=True)
    return o * lax.rsqrt(ms + LN_EPS) * g.astype(F32).reshape(o.shape[2:])


def swiglu(x, w_gate, w_up, w_down):
    return (jax.nn.silu(x @ w_gate) * (x @ w_up)) @ w_down


def rotary(x, pos):
    half = x.shape[-1] // 2
    inv_freq = ROPE_BASE ** (-jnp.arange(half, dtype=F32) / half)
    ang = pos.astype(F32)[:, None] * inv_freq[None, :]
    cos = jnp.cos(ang)[None, :, None, :]
    sin = jnp.sin(ang)[None, :, None, :]
    xf = x.astype(F32)
    x1, x2 = xf[..., :half], xf[..., half:]
    return jnp.concatenate([x1 * cos - x2 * sin, x1 * sin + x2 * cos], axis=-1).astype(x.dtype)


def _chunk_scan(q, k, v, log_a, s0):
    bsz, t = q.shape[:2]
    c = math.gcd(t, CHUNK)
    n = t // c

    def blocks(a):
        a = a.astype(F32)
        return a.reshape((bsz, n, c) + a.shape[2:]).swapaxes(0, 1)

    mask = jnp.tril(jnp.ones((c, c), dtype=bool))
    vector_decay = log_a.shape[-1] > 1

    def step(s, blk):
        qc, kc, vc, gc = blk
        g = jnp.cumsum(gc, axis=1)
        if vector_decay:
            diff = g[:, :, None] - g[:, None]
            dec = jnp.exp(jnp.where(mask[None, :, :, None, None], diff, -jnp.inf))
            att = jnp.einsum('bihk,bijhk,bjhk->bijh', qc, dec, kc)
        else:
            gs = g[..., 0]
            diff = gs[:, :, None] - gs[:, None]
            dec = jnp.exp(jnp.where(mask[None, :, :, None], diff, -jnp.inf))
            att = jnp.einsum('bihk,bjhk->bijh', qc, kc) * dec
        o = jnp.einsum('bijh,bjhv->bihv', att, vc) + jnp.einsum('bihk,bhkv->bihv', qc * jnp.exp(g), s)
        g_last = g[:, -1]
        k_dec = kc * jnp.exp(g_last[:, None] - g)
        s = jnp.exp(g_last)[..., None] * s + jnp.einsum('bjhk,bjhv->bhkv', k_dec, vc)
        return s, o

    s, o = lax.scan(step, s0.astype(F32), (blocks(q), blocks(k), blocks(v), blocks(log_a)))
    return o.swapaxes(0, 1).reshape((bsz, t) + o.shape[3:]), s


def recur(q, k, v, log_a, s0, n_lead):
    t = q.shape[1]
    outs = []
    s = s0
    for lo, hi in ((0, n_lead), (n_lead, t)):
        if hi > lo:
            o, s = _chunk_scan(q[:, lo:hi], k[:, lo:hi], v[:, lo:hi], log_a[:, lo:hi], s)
            outs.append(o)
    return jnp.concatenate(outs, axis=1), s


def causal_depthwise_conv(xcat, w, b):
    y = lax.conv_general_dilated(
        xcat, w.astype(xcat.dtype)[:, None, :], window_strides=(1,), padding='VALID',
        dimension_numbers=('NWC', 'WIO', 'NWC'), feature_group_count=xcat.shape[-1])
    return y + b.astype(xcat.dtype)


def hgrn2_mixer(x, s0, w_in, norm_g, w_o, lb, n_lead):
    bsz, t, _ = x.shape
    fw = HG_HEADS * HG_DK
    vw = HG_HEADS * HG_DV
    proj = x @ w_in
    q = jax.nn.silu(proj[..., :fw]).reshape(bsz, t, HG_HEADS, HG_DK)
    z = proj[..., fw:2 * fw].astype(F32)
    inp = proj[..., 2 * fw:2 * fw + vw].reshape(bsz, t, HG_HEADS, HG_DV)
    gate = proj[..., 2 * fw + vw:]
    f = lb + (1.0 - lb) * jax.nn.sigmoid(z)
    k = ((1.0 - lb) * jax.nn.sigmoid(-z)).reshape(bsz, t, HG_HEADS, HG_DK)
    log_f = jnp.log(f).reshape(bsz, t, HG_HEADS, HG_DK)
    o, s = recur(q, k, inp, log_f, s0, n_lead)
    o = head_rms_norm(o, norm_g).reshape(bsz, t, vw).astype(x.dtype) * jax.nn.silu(gate)
    return o @ w_o, s


def retention_mixer(x, s0, w_in, norm_g, w_o, pos, n_lead):
    bsz, t, _ = x.shape
    qk = RET_HEADS * RET_DK
    vw = RET_HEADS * RET_DV
    proj = x @ w_in
    q = rotary(proj[..., :qk].reshape(bsz, t, RET_HEADS, RET_DK), pos)
    k = rotary(proj[..., qk:2 * qk].reshape(bsz, t, RET_HEADS, RET_DK), pos) * (RET_DK ** -0.5)
    v = proj[..., 2 * qk:2 * qk + vw].reshape(bsz, t, RET_HEADS, RET_DV)
    gate = proj[..., 2 * qk + vw:]
    log_gamma = jnp.log(1.0 - 2.0 ** (-5.0 - jnp.arange(RET_HEADS, dtype=F32)))
    log_a = jnp.broadcast_to(log_gamma[None, None, :, None], (bsz, t, RET_HEADS, 1))
    o, s = recur(q, k, v, log_a, s0, n_lead)
    o = head_layer_norm(o, norm_g).reshape(bsz, t, vw).astype(x.dtype) * jax.nn.silu(gate)
    return o @ w_o, s


def mamba2_mixer(x, s0, conv0, w_in, conv_w, conv_b, dt_bias, a_log, d_skip, norm_g, w_o, n_lead):
    bsz, t, _ = x.shape
    proj = x @ w_in
    z = proj[..., :M_DI]
    xbc = proj[..., M_DI:M_DI + M_CONV_DIM]
    dt_raw = proj[..., M_DI + M_CONV_DIM:]
    xcat = jnp.concatenate([conv0.astype(xbc.dtype), xbc], axis=1)
    new_conv = xcat[:, -(M_CONV - 1):]
    xbc = jax.nn.silu(causal_depthwise_conv(xcat, conv_w, conv_b))
    gn = M_GROUPS * M_DSTATE
    rep = M_HEADS // M_GROUPS
    xs = xbc[..., :M_DI].reshape(bsz, t, M_HEADS, M_HEADDIM)
    bm = jnp.repeat(xbc[..., M_DI:M_DI + gn].reshape(bsz, t, M_GROUPS, M_DSTATE), rep, axis=2)
    cm = jnp.repeat(xbc[..., M_DI + gn:].reshape(bsz, t, M_GROUPS, M_DSTATE), rep, axis=2)
    dt = jax.nn.softplus(dt_raw.astype(F32) + dt_bias.astype(F32))
    log_a = (dt * -jnp.exp(a_log.astype(F32)))[..., None]
    xf = xs.astype(F32)
    o, s = recur(cm, bm, xf * dt[..., None], log_a, s0, n_lead)
    y = o + d_skip.astype(F32)[:, None] * xf
    y = y.reshape(bsz, t, M_DI) * jax.nn.silu(z.astype(F32))
    yg = y.reshape(bsz, t, M_GROUPS, M_DI // M_GROUPS)
    yg = yg * lax.rsqrt(jnp.mean(jnp.square(yg), axis=-1, keepdims=True) + LN_EPS)
    y = (yg.reshape(bsz, t, M_DI) * norm_g.astype(F32)).astype(x.dtype)
    return y @ w_o, s, new_conv


def run_trunk(h, st_hg, st_ret, st_ssm, st_conv, pos, n_lead, p):
    lb_all = jnp.cumsum(jax.nn.softmax(p['hg_lb_logits'].astype(F32), axis=0), axis=0)
    lb_all = lb_all - lb_all[0]
    new_hg, new_ret, new_ssm, new_conv = [], [], [], []
    for i in range(DEPTH):
        h = layer_norm(ALPHA * h + 0.5 * swiglu(h, p['ffn_w_gate'][i, 0], p['ffn_w_up'][i, 0], p['ffn_w_down'][i, 0]),
                       p['ln_g'][i, 0], p['ln_b'][i, 0])
        kind, j = i % N_MIXERS, i // N_MIXERS
        if kind == 0:
            m, s = hgrn2_mixer(h, st_hg[j], p['hg_w_in'][j], p['hg_norm_g'][j], p['hg_w_o'][j], lb_all[i], n_lead)
            new_hg.append(s)
        elif kind == 1:
            m, s = retention_mixer(h, st_ret[j], p['ret_w_in'][j], p['ret_norm_g'][j], p['ret_w_o'][j], pos, n_lead)
            new_ret.append(s)
        else:
            m, s, c = mamba2_mixer(h, st_ssm[j], st_conv[j], p['m_w_in'][j], p['m_conv_w'][j], p['m_conv_b'][j],
                                   p['m_dt_bias'][j], p['m_a_log'][j], p['m_d'][j], p['m_norm_g'][j], p['m_w_o'][j], n_lead)
            new_ssm.append(s)
            new_conv.append(c)
        h = layer_norm(ALPHA * h + m, p['ln_g'][i, 1], p['ln_b'][i, 1])
        h = layer_norm(ALPHA * h + 0.5 * swiglu(h, p['ffn_w_gate'][i, 1], p['ffn_w_up'][i, 1], p['ffn_w_down'][i, 1]),
                       p['ln_g'][i, 2], p['ln_b'][i, 2])
    return h, jnp.stack(new_hg), jnp.stack(new_ret), jnp.stack(new_ssm), jnp.stack(new_conv)


def setup_inputs(seed: int = 0) -> dict:
    key = jax.random.key(seed)
    ks = jax.random.split(key, 32)

    def nrm(k, shape, scale):
        return jax.random.normal(k, shape, F32) * scale

    fw = HG_HEADS * HG_DK
    hvw = HG_HEADS * HG_DV
    hg_cols = 2 * fw + 2 * hvw
    hg_scale = jnp.ones((hg_cols,), F32).at[2 * fw:2 * fw + hvw].set(BETA) * D_MODEL ** -0.5
    qk = RET_HEADS * RET_DK
    rvw = RET_HEADS * RET_DV
    ret_cols = 2 * qk + 2 * rvw
    ret_scale = jnp.ones((ret_cols,), F32).at[2 * qk:2 * qk + rvw].set(BETA) * D_MODEL ** -0.5
    m_cols = M_DI + M_CONV_DIM + M_HEADS
    dt0 = jnp.exp(jax.random.uniform(ks[22], (N_SSM_LAYERS, M_HEADS), F32)
                  * (math.log(0.1) - math.log(0.001)) + math.log(0.001))
    return {
        'x_prompt': nrm(ks[0], (BATCH, SEQ, D_MODEL), 1.0),
        'x_sample': nrm(ks[1], (DEC_BATCH, DEC_SEQ, D_MODEL), 1.0),
        'state_hgrn': nrm(ks[2], (N_HG_LAYERS, DEC_BATCH, HG_HEADS, HG_DK, HG_DV), 0.5),
        'state_ret': nrm(ks[3], (N_RET_LAYERS, DEC_BATCH, RET_HEADS, RET_DK, RET_DV), 1.0),
        'state_ssm': nrm(ks[4], (N_SSM_LAYERS, DEC_BATCH, M_HEADS, M_DSTATE, M_HEADDIM), 0.5),
        'state_conv': nrm(ks[5], (N_SSM_LAYERS, DEC_BATCH, M_CONV - 1, M_CONV_DIM), 1.0),
        'meta_tokens': nrm(ks[6], (N_META, D_MODEL), 1.0),
        'ln_g': 1.0 + nrm(ks[7], (DEPTH, 3, D_MODEL), 0.02),
        'ln_b': nrm(ks[8], (DEPTH, 3, D_MODEL), 0.02),
        'ffn_w_gate': nrm(ks[9], (DEPTH, 2, D_MODEL, D_FF), D_MODEL ** -0.5),
        'ffn_w_up': nrm(ks[10], (DEPTH, 2, D_MODEL, D_FF), D_MODEL ** -0.5),
        'ffn_w_down': nrm(ks[11], (DEPTH, 2, D_FF, D_MODEL), BETA * D_FF ** -0.5),
        'hg_lb_logits': nrm(ks[12], (DEPTH, fw), 1.0),
        'hg_w_in': nrm(ks[13], (N_HG_LAYERS, D_MODEL, hg_cols), 1.0) * hg_scale,
        'hg_norm_g': 1.0 + nrm(ks[14], (N_HG_LAYERS, hvw), 0.02),
        'hg_w_o': nrm(ks[15], (N_HG_LAYERS, hvw, D_MODEL), BETA * hvw ** -0.5),
        'ret_w_in': nrm(ks[16], (N_RET_LAYERS, D_MODEL, ret_cols), 1.0) * ret_scale,
        'ret_norm_g': 1.0 + nrm(ks[17], (N_RET_LAYERS, rvw), 0.02),
        'ret_w_o': nrm(ks[18], (N_RET_LAYERS, rvw, D_MODEL), BETA * rvw ** -0.5),
        'm_w_in': nrm(ks[19], (N_SSM_LAYERS, D_MODEL, m_cols), D_MODEL ** -0.5),
        'm_conv_w': nrm(ks[20], (N_SSM_LAYERS, M_CONV, M_CONV_DIM), M_CONV ** -0.5),
        'm_conv_b': nrm(ks[21], (N_SSM_LAYERS, M_CONV_DIM), 0.02),
        'm_dt_bias': dt0 + jnp.log(-jnp.expm1(-dt0)),
        'm_a_log': jnp.log(jax.random.uniform(ks[23], (N_SSM_LAYERS, M_HEADS), F32, minval=1.0, maxval=16.0)),
        'm_d': 1.0 + nrm(ks[24], (N_SSM_LAYERS, M_HEADS), 0.1),
        'm_norm_g': 1.0 + nrm(ks[25], (N_SSM_LAYERS, M_DI), 0.02),
        'm_w_o': nrm(ks[26], (N_SSM_LAYERS, M_DI, D_MODEL), BETA * M_DI ** -0.5),
    }


def reference(x_prompt, x_sample, state_hgrn, state_ret, state_ssm, state_conv, meta_tokens, ln_g, ln_b,
              ffn_w_gate, ffn_w_up, ffn_w_down, hg_lb_logits, hg_w_in, hg_norm_g, hg_w_o,
              ret_w_in, ret_norm_g, ret_w_o, m_w_in, m_conv_w, m_conv_b, m_dt_bias, m_a_log, m_d,
              m_norm_g, m_w_o):
    p = {
        'ln_g': ln_g, 'ln_b': ln_b, 'ffn_w_gate': ffn_w_gate, 'ffn_w_up': ffn_w_up, 'ffn_w_down': ffn_w_down,
        'hg_lb_logits': hg_lb_logits, 'hg_w_in': hg_w_in, 'hg_norm_g': hg_norm_g, 'hg_w_o': hg_w_o,
        'ret_w_in': ret_w_in, 'ret_norm_g': ret_norm_g, 'ret_w_o': ret_w_o,
        'm_w_in': m_w_in, 'm_conv_w': m_conv_w, 'm_conv_b': m_conv_b, 'm_dt_bias': m_dt_bias,
        'm_a_log': m_a_log, 'm_d': m_d, 'm_norm_g': m_norm_g, 'm_w_o': m_w_o,
    }
    bp, sp, _ = x_prompt.shape
    h_p = jnp.concatenate(
        [jnp.broadcast_to(meta_tokens[None].astype(x_prompt.dtype), (bp, N_META, D_MODEL)), x_prompt], axis=1)
    pos_p = jnp.arange(N_META + sp)
    z_hg = jnp.zeros((N_HG_LAYERS, bp, HG_HEADS, HG_DK, HG_DV), F32)
    z_ret = jnp.zeros((N_RET_LAYERS, bp, RET_HEADS, RET_DK, RET_DV), F32)
    z_ssm = jnp.zeros((N_SSM_LAYERS, bp, M_HEADS, M_DSTATE, M_HEADDIM), F32)
    z_conv = jnp.zeros((N_SSM_LAYERS, bp, M_CONV - 1, M_CONV_DIM), x_prompt.dtype)
    h_p, hgrn_prompt, ret_prompt, ssm_prompt, conv_prompt = run_trunk(
        h_p, z_hg, z_ret, z_ssm, z_conv, pos_p, N_META, p)
    y_prompt = h_p[:, N_META:]
    pos_s = PAST_LEN + jnp.arange(x_sample.shape[1])
    y_sample, hgrn_sample, ret_sample, ssm_sample, conv_sample = run_trunk(
        x_sample, state_hgrn, state_ret, state_ssm, state_conv, pos_s, 0, p)
    return (y_prompt, y_sample, hgrn_prompt, hgrn_sample, ret_prompt, ret_sample,
            ssm_prompt, ssm_sample, conv_prompt, conv_sample)
```

```cpp
#include <hip/hip_runtime.h>
#include <hip/hip_cooperative_groups.h>
#include <cstdio>
namespace cg = cooperative_groups;

#define LAS __attribute__((address_space(3)))
typedef unsigned short bf16_t;
typedef short bf16x8 __attribute__((ext_vector_type(8)));
typedef float f32x4 __attribute__((ext_vector_type(4)));
typedef unsigned u32x4 __attribute__((ext_vector_type(4)));
typedef unsigned u32x2 __attribute__((ext_vector_type(2)));

constexpr int D = 1024, TP = 2064, RP = 8 * TP  , RS_ = 1024, M_ = RP + RS_  , MP = 17664, DFF = 2816;
constexpr int NPOS = TP + 8;
constexpr float ALPHA = 1.681792830507429f, LN_EPS = 1e-5f;
constexpr int LDS_BYTES = 163840;

constexpr size_t O_YP = 0, O_YS = O_YP + 8ull * 2048 * 1024, O_HGP = O_YS + 128ull * 8 * 1024, O_HGS = O_HGP + 2ull * 8 * 8 * 128 * 128,
                 O_RTP = O_HGS + 2ull * 128 * 8 * 128 * 128, O_RTS = O_RTP + 8ull * 4 * 256 * 512, O_SSP = O_RTS + 128ull * 4 * 256 * 512,
                 O_SSS = O_SSP + 8ull * 32 * 128 * 64, O_CVP = O_SSS + 128ull * 32 * 128 * 64, O_CVS = O_CVP + 8ull * 3 * 4096;

constexpr size_t al256(size_t x) { return (x + 255) & ~(size_t)255; }
constexpr size_t W_GU = 0;
constexpr size_t W_D = W_GU + 8ull * 5632 * 1024 * 2;
constexpr size_t W_HGI = W_D + 8ull * 1024 * 2816 * 2;
constexpr size_t W_HGO = W_HGI + 2ull * 4096 * 1024 * 2;
constexpr size_t W_RI = W_HGO + 2ull * 1024 * 1024 * 2;
constexpr size_t W_RO = W_RI + 6144ull * 1024 * 2;
constexpr size_t W_MI = W_RO + 1024ull * 2048 * 2;
constexpr size_t W_MO = W_MI + 6400ull * 1024 * 2;
constexpr size_t B_HF = W_MO + 1024ull * 2048 * 2;
constexpr size_t B_PARTB = B_HF;
constexpr size_t B_HB = B_HF + (size_t)MP * 1024 * 4;
constexpr size_t B_ACT = B_HB + (size_t)MP * 1024 * 2;
constexpr size_t B_PART = B_ACT + (size_t)MP * 2816 * 2;
constexpr size_t B_PROJ = B_PART + 2ull * MP * 1024 * 4;
constexpr size_t B_ROPE = B_PROJ + (size_t)MP * 21504;
constexpr size_t B_LB = B_ROPE + 2ull * NPOS * 128 * 4;
constexpr size_t B_BAR = B_LB + 2 * 1024 * 4;
constexpr size_t B_HB8 = B_BAR + 3456 * 4 + 256;
constexpr size_t WS_END = B_HB8 + (size_t)MP * 1024;

struct Args {
    const float* in[27];
    float* out;
    unsigned char* ws;
    int ph_lo, ph_hi;
};

#ifndef REP_SMP
#define REP_SMP 1
#endif
#ifndef REP_GEMM
#define REP_GEMM 1
#endif
typedef const Args __attribute__((address_space(4)))* ArgsP;
__device__ __forceinline__ ArgsP launder(ArgsP p) { asm volatile("" : "+s"(p)); return p; }
#define AIN(k) ((const float*)a->in[k])
__device__ __forceinline__ int TID() { int t = threadIdx.x; asm volatile("" : "+v"(t)); return t; }
__device__ __forceinline__ int BID() { int t = blockIdx.x; asm volatile("" : "+s"(t)); return t; }
__device__ __forceinline__ unsigned cvt_pk_bf16(float lo, float hi) { unsigned r; asm("v_cvt_pk_bf16_f32 %0, %1, %2" : "=v"(r) : "v"(lo), "v"(hi)); return r; }
__device__ __forceinline__ bf16_t f2bf(float f) { return (bf16_t)(cvt_pk_bf16(f, 0.f) & 0xffffu); }
__device__ __forceinline__ float bf2f(bf16_t b) { return __uint_as_float(((unsigned)b) << 16); }
__device__ __forceinline__ float siluf(float x) { return x * __builtin_amdgcn_rcpf(1.0f + __expf(-x)); }
typedef int i32x4 __attribute__((ext_vector_type(4)));
typedef int i32x8 __attribute__((ext_vector_type(8)));
__device__ __forceinline__ float clamp448(float x) { return fminf(fmaxf(x, -448.f), 448.f); }
__device__ __forceinline__ unsigned pk_fp8x4(float a, float b, float c, float d) { int w = 0; w = __builtin_amdgcn_cvt_pk_fp8_f32(clamp448(a), clamp448(b), w, false); w = __builtin_amdgcn_cvt_pk_fp8_f32(clamp448(c), clamp448(d), w, true); return (unsigned)w; }
constexpr float SC_H = 11.3f, SC_WGU = 181.f, SC_ACT = 5.66f, SC_WD = 724.f;
__device__ __forceinline__ float wave_sum(float v) {
#pragma unroll
    for (int o = 32; o >= 1; o >>= 1) v += __shfl_xor(v, o);
    return v;
}
__device__ __forceinline__ int pos_index(int row) { return row < RP ? row % TP : (row < M_ ? TP + ((row - RP) & 7) : 0); }


#define XB_TMO      128
#define XB_XCNT(j)  (256  + 64 * (j))
#define XB_XSUB(j)  (1280 + 64 * (j))
#define XB_XGEN(j)  (2304 + 64 * (j))
#define XB_TOP      3328
#define XB_TOPGEN   3392
#define XCD_BAR_WORDS 3456
#define XB_SPIN_CAP (1u << 18)
__device__ __forceinline__ unsigned xb_ld(unsigned* p)              { return __hip_atomic_load(p, __ATOMIC_RELAXED, __HIP_MEMORY_SCOPE_AGENT); }
__device__ __forceinline__ unsigned xb_add(unsigned* p, unsigned v) { return __hip_atomic_fetch_add(p, v, __ATOMIC_RELAXED, __HIP_MEMORY_SCOPE_AGENT); }
__device__ __forceinline__ unsigned xb_xcc_id() { return (unsigned)__builtin_amdgcn_s_getreg((3 << 11) | 20) & 0xFu; }
#define XB_SPIN(cond, bar) do { unsigned _sp = 0; while (cond) { __builtin_amdgcn_s_sleep(1); \
    if ((++_sp & 255u) == 0u) { if (xb_ld(&(bar)[XB_TMO])) break; if (_sp > XB_SPIN_CAP) { atomicAdd(&(bar)[XB_TMO], 1u); break; } } } } while (0)
struct XcdBarrier { unsigned* bar; unsigned x; volatile LAS unsigned* st; };
__device__ __forceinline__ XcdBarrier xcd_barrier_post(unsigned* bar, volatile LAS unsigned* st) {
    XcdBarrier b; b.bar = bar; b.x = xb_xcc_id(); b.st = st;
    if (threadIdx.x == 0) (void)xb_add(&bar[XB_XCNT(b.x)], 1u);
    return b;
}
__device__ __forceinline__ void xcd_barrier_complete(unsigned* bar, unsigned x, unsigned& nloc, unsigned& nx) {
    const unsigned G = gridDim.x * gridDim.y * gridDim.z;
    unsigned sum, cnt, mine, sp = 0u;
    for (;;) {
        sum = 0u; cnt = 0u; mine = 0u;
#pragma unroll
        for (unsigned j = 0; j < 16; ++j) { const unsigned c = xb_ld(&bar[XB_XCNT(j)]); sum += c; cnt += (c > 0u) ? 1u : 0u; mine = (j == x) ? c : mine; }
        if (sum == G) break;
        __builtin_amdgcn_s_sleep(1);
        if ((++sp & 255u) == 0u) { if (xb_ld(&bar[XB_TMO])) break; if (sp > XB_SPIN_CAP) { atomicAdd(&bar[XB_TMO], 1u); break; } }
    }
    nloc = mine > 0u ? mine : 1u; nx = cnt > 0u ? cnt : 1u;
}
__device__ __forceinline__ void xcd_barrier(const XcdBarrier& b) {
    asm volatile("s_waitcnt vmcnt(0)" ::: "memory");
    __syncthreads();
    if (threadIdx.x == 0) {
        unsigned* bar = b.bar;
        __builtin_amdgcn_s_waitcnt(0);
        unsigned nloc = b.st[0], nx = b.st[1];
        if (nloc == 0u) { xcd_barrier_complete(bar, b.x, nloc, nx); b.st[0] = nloc; b.st[1] = nx; }
        const unsigned old = xb_add(&bar[XB_XSUB(b.x)], 1u);
        const unsigned gen = old / nloc;
        if (old + 1u == (gen + 1u) * nloc) {
            __builtin_amdgcn_fence(__ATOMIC_RELEASE, "agent");
            asm volatile("s_waitcnt vmcnt(0)" ::: "memory");
            const unsigned og = xb_add(&bar[XB_TOP], 1u);
            const unsigned tg = og / nx;
            if (og + 1u == (tg + 1u) * nx) xb_add(&bar[XB_TOPGEN], 1u);
            else XB_SPIN(xb_ld(&bar[XB_TOPGEN]) == tg, bar);
            __builtin_amdgcn_fence(__ATOMIC_ACQUIRE, "agent");
            xb_add(&bar[XB_XGEN(b.x)], 1u);
            asm volatile("s_waitcnt vmcnt(0)" ::: "memory");
        } else {
            XB_SPIN(xb_ld(&bar[XB_XGEN(b.x)]) == gen, bar);
            __builtin_amdgcn_fence(__ATOMIC_ACQUIRE, "agent");
            asm volatile("s_waitcnt vmcnt(0)" ::: "memory");
        }
    }
    __syncthreads();
}

namespace pg8 {
constexpr int BM = 256, BK = 64, HALF = 128, HTB = HALF * BK * 2, NXCD = 8, WGM = 8;
__device__ __forceinline__ int lds_byte(int r, int c) { const int st = (r >> 4) * 2 + (c >> 5), rr = r & 15, cc = c & 31, ob = rr * 64 + cc * 2; return st * 1024 + (ob ^ (((ob >> 9) & 1) << 5)); }
__device__ __forceinline__ void stage_rc(int b, int& R, int& C) { const int st = b / 1024, sb = b % 1024, swz = sb ^ (((sb >> 9) & 1) << 5); R = (st >> 1) * 16 + swz / 64; C = (st & 1) * 32 + (swz % 64) / 2; }
__device__ __forceinline__ int perm32(int rho) { const int n = rho >> 4, i = rho & 15; return 8 * (i >> 2) + 4 * n + (i & 3); }

struct Unit { int pm, pn, s, kb, nt, full; };
struct Gemm { const bf16_t* A; const bf16_t* Bt; int lda, ldb, K; };

struct SplitOrder {
    int nM, nN, nS, nwg, G, c, nk, sk;
    __device__ void init(int nM_, int nN_, int nS_, int G_, int c_) { nM = nM_; nN = nN_; nS = nS_; nwg = nM * nN; G = G_; c = c_; nk = 0; sk = 0; }
    __device__ void init_sk(int nM_, int nN_, int nk_, int G_, int c_) { nM = nM_; nN = nN_; nS = 2; nwg = nM * nN; G = G_; c = (G_ % 8 == 0) ? (c_ % 8) * (G_ / 8) + c_ / 8 : c_; nk = nk_; sk = 1; }
    __device__ long bnd(int cc) const { const long total = (long)nwg * nk; if (cc >= G) return total; const long base = total / G, rem = total % G; long s_ = (long)cc * base + (cc < rem ? cc : rem);
        const int r = (int)(s_ % nk); if (r == 1) s_ -= 1; else if (r == nk - 1) s_ += 1; return s_; }
    __device__ bool next(int i, Unit& u) const {
        if (sk) {
            const long s0 = bnd(c), s1 = bnd(c + 1); long s_ = s0;
            for (int k = 0; k < i; ++k) { const long te = (s_ / nk + 1) * nk; s_ = te < s1 ? te : s1; }
            if (s_ >= s1) return false;
            const int t = (int)(s_ / nk), kb = (int)(s_ % nk); const long te = (long)(t + 1) * nk; const long e = te < s1 ? te : s1; const int len = (int)(e - s_);
            u.pm = __builtin_amdgcn_readfirstlane(t / nN); u.pn = __builtin_amdgcn_readfirstlane(t % nN); u.kb = __builtin_amdgcn_readfirstlane(kb); u.nt = __builtin_amdgcn_readfirstlane(2 * len); u.s = kb == 0 ? 0 : 1; u.full = (kb == 0 && len == nk) ? 1 : 0;
            u.s = __builtin_amdgcn_readfirstlane(u.s); u.full = __builtin_amdgcn_readfirstlane(u.full); return true;
        }
        const long L = (long)i * G + c; if (L >= (long)nwg * nS) return false;
        u.s = (int)(L / nwg); int wgid = (int)(L % nwg);
        { const int q = nwg / NXCD, r = nwg % NXCD, xcd = wgid % NXCD, off = wgid / NXCD; wgid = (xcd < r ? xcd * (q + 1) : r * (q + 1) + (xcd - r) * q) + off; }
        const int nig = WGM * nN, gid = wgid / nig, fm = gid * WGM, gsz = (nM - fm) < WGM ? (nM - fm) : WGM;
        u.pm = __builtin_amdgcn_readfirstlane(fm + ((wgid % nig) % gsz)); u.pn = __builtin_amdgcn_readfirstlane((wgid % nig) / gsz); u.s = __builtin_amdgcn_readfirstlane(u.s); u.kb = 0; u.nt = 0; u.full = 0; return true;
    }
};

template <class Epi, bool FP8>
__device__ __forceinline__ void gemm_phase(LAS unsigned char* lds, const Gemm g, const SplitOrder& S, const Epi& E) {
    const int tid = TID(), wid = __builtin_amdgcn_readfirstlane(tid >> 6), lane = tid & 63, wr = wid >> 2, wc = wid & 3, fr = lane & 15, fq = lane >> 4;
    const int nt0 = g.K / BK;
    unsigned voffA[2], voffB[2];
#pragma unroll
    for (int i = 0; i < 2; ++i) { int R, C; stage_rc(tid * 16 + i * 8192, R, C); const int Rb = Epi::PERM ? ((R & ~31) + perm32(R & 31)) : R;
        voffA[i] = (unsigned)(R * g.lda + C) * 2u; voffB[i] = (unsigned)(Rb * g.ldb + C) * 2u; }
    const size_t kstep = (size_t)(BK * 2);
    const size_t hstepA = (size_t)HALF * g.lda * 2, hstepB = (size_t)HALF * g.ldb * 2;
    const size_t tstepA = 2 * hstepA, tstepB = 2 * hstepB, ksb = (size_t)g.K * 2;
    const unsigned ldsw = (unsigned)wid * 1024u;
    const int aoff = lds_byte(wr * 64 + fr, fq * 8), boff = lds_byte(wc * 32 + fr, fq * 8);
#define PG8_SA(b, h) (((b) * 2 + (h)) * HTB)
#define PG8_SB(b, h) ((4 + (b) * 2 + (h)) * HTB)
#define PG8_STAGE(bufoff, gbase, voff) do { _Pragma("unroll") for (int _i = 0; _i < 2; ++_i) \
        __builtin_amdgcn_global_load_lds((const unsigned*)((const char*)(gbase) + (voff)[_i]), (LAS unsigned*)(lds + (bufoff) + ldsw + _i * 8192), 16, 0, 0); } while (0)
#define PG8_LDA(dst, b, h) do { _Pragma("unroll") for (int m = 0; m < 4; ++m) { if (FP8) dst##8[m] = __builtin_shufflevector(*(const LAS i32x4*)(lds + PG8_SA(b, h) + aoff + m * 2048), *(const LAS i32x4*)(lds + PG8_SA(b, h) + aoff + m * 2048 + 1024), 0, 1, 2, 3, 4, 5, 6, 7); \
        else { _Pragma("unroll") for (int k = 0; k < 2; ++k) dst[m][k] = *(const LAS bf16x8*)(lds + PG8_SA(b, h) + aoff + m * 2048 + k * 1024); } } } while (0)
#define PG8_LDB(dst, b, h) do { _Pragma("unroll") for (int n = 0; n < 2; ++n) { if (FP8) dst##8[n] = __builtin_shufflevector(*(const LAS i32x4*)(lds + PG8_SB(b, h) + boff + n * 2048), *(const LAS i32x4*)(lds + PG8_SB(b, h) + boff + n * 2048 + 1024), 0, 1, 2, 3, 4, 5, 6, 7); \
        else { _Pragma("unroll") for (int k = 0; k < 2; ++k) dst[n][k] = *(const LAS bf16x8*)(lds + PG8_SB(b, h) + boff + n * 2048 + k * 1024); } } } while (0)
#define PG8_MMA(ai, bj, At, Bt) do { __builtin_amdgcn_s_setprio(1); _Pragma("unroll") for (int m = 0; m < 4; ++m) _Pragma("unroll") for (int n = 0; n < 2; ++n) { \
        if (FP8) asm volatile("v_mfma_f32_16x16x128_f8f6f4 %0, %1, %2, %0" : "+v"(acc[ai][bj][m][n]) : "v"(Bt##8[n]), "v"(At##8[m])); \
        else { _Pragma("unroll") for (int k = 0; k < 2; ++k) acc[ai][bj][m][n] = __builtin_amdgcn_mfma_f32_16x16x32_bf16(Bt[n][k], At[m][k], acc[ai][bj][m][n], 0, 0, 0); } } \
        __builtin_amdgcn_s_setprio(0); } while (0)
#define PG8_WAIT_V(n) asm volatile("s_waitcnt vmcnt(" #n ")" ::: "memory")
#define PG8_WAIT_L(n) asm volatile("s_waitcnt lgkmcnt(" #n ")" ::: "memory")
#define PG8_BAR __builtin_amdgcn_s_barrier()
#define PG8_SCHED __builtin_amdgcn_sched_barrier(0)
    Unit cur, nxt; int ui = 0;
    if (!S.next(0, cur)) return;
    f32x4 acc[2][2][4][2];
#pragma unroll
    for (int a = 0; a < 2; ++a)
#pragma unroll
        for (int b = 0; b < 2; ++b)
#pragma unroll
            for (int m = 0; m < 4; ++m)
#pragma unroll
                for (int n = 0; n < 2; ++n) acc[a][b][m][n] = (f32x4){0.f, 0.f, 0.f, 0.f};
    bf16x8 At[4][2], B0[2][2], B1[2][2]; i32x8 At8[4], B08[2], B18[2];
    const bool sk = S.sk != 0;
    const char* cA = (const char*)g.A + (size_t)cur.pm * tstepA + (sk ? (size_t)cur.kb * 256 : (size_t)cur.s * ksb); const char* cB = (const char*)g.Bt + (size_t)cur.pn * tstepB + (sk ? (size_t)cur.kb * 256 : (size_t)cur.s * ksb);
    PG8_STAGE(PG8_SB(0, 0), cB, voffB); PG8_STAGE(PG8_SA(0, 0), cA, voffA); PG8_STAGE(PG8_SB(0, 1), cB + hstepB, voffB); PG8_STAGE(PG8_SA(0, 1), cA + hstepA, voffA);
    if (wr == 1) PG8_BAR;
    PG8_WAIT_V(4); PG8_BAR;
    PG8_STAGE(PG8_SB(1, 0), cB + kstep, voffB); PG8_STAGE(PG8_SA(1, 0), cA + kstep, voffA); PG8_STAGE(PG8_SB(1, 1), cB + hstepB + kstep, voffB);
    PG8_WAIT_V(6); PG8_BAR;
    for (;;) {
        const bool has_next = S.next(ui + 1, nxt);
        const char* nA = has_next ? (const char*)g.A + (size_t)nxt.pm * tstepA + (sk ? (size_t)nxt.kb * 256 : (size_t)nxt.s * ksb) : cA; const char* nB = has_next ? (const char*)g.Bt + (size_t)nxt.pn * tstepB + (sk ? (size_t)nxt.kb * 256 : (size_t)nxt.s * ksb) : cB;
        const int nt = sk ? cur.nt : nt0;
        for (int t = 0; t < nt; t += 2) {
            const bool last = (t == nt - 2);
            const char* a1 = cA + (size_t)(t + 1) * kstep;
            const char* a2 = last ? nA : cA + (size_t)(t + 2) * kstep; const char* b2 = last ? nB : cB + (size_t)(t + 2) * kstep;
            const char* a3 = a2 + kstep; const char* b3 = b2 + kstep;
            PG8_LDB(B0, 0, 0); PG8_SCHED; PG8_LDA(At, 0, 0); PG8_STAGE(PG8_SA(1, 1), a1 + hstepA, voffA);
            PG8_WAIT_L(8); PG8_BAR; PG8_WAIT_L(0); PG8_MMA(0, 0, At, B0); PG8_BAR; PG8_SCHED;
            PG8_LDB(B1, 0, 1); PG8_STAGE(PG8_SB(0, 0), b2, voffB);
            PG8_BAR; PG8_WAIT_L(0); PG8_MMA(0, 1, At, B1); PG8_BAR;
            PG8_LDA(At, 0, 1); PG8_STAGE(PG8_SA(0, 0), a2, voffA);
            PG8_BAR; PG8_WAIT_L(0); PG8_MMA(1, 0, At, B0); PG8_BAR; PG8_SCHED;
            PG8_STAGE(PG8_SB(0, 1), b2 + hstepB, voffB);
            PG8_WAIT_V(6); PG8_BAR; PG8_MMA(1, 1, At, B1); PG8_BAR;
            PG8_LDB(B0, 1, 0); PG8_SCHED; PG8_LDA(At, 1, 0); PG8_STAGE(PG8_SA(0, 1), a2 + hstepA, voffA);
            PG8_WAIT_L(8); PG8_BAR; PG8_WAIT_L(0); PG8_MMA(0, 0, At, B0); PG8_BAR; PG8_SCHED;
            PG8_LDB(B1, 1, 1); PG8_STAGE(PG8_SB(1, 0), b3, voffB);
            PG8_BAR; PG8_WAIT_L(0); PG8_MMA(0, 1, At, B1); PG8_BAR;
            PG8_LDA(At, 1, 1); PG8_STAGE(PG8_SA(1, 0), a3, voffA);
            PG8_BAR; PG8_WAIT_L(0); PG8_MMA(1, 0, At, B0); PG8_BAR; PG8_SCHED;
            PG8_STAGE(PG8_SB(1, 1), b3 + hstepB, voffB);
            PG8_WAIT_V(6); PG8_BAR; PG8_MMA(1, 1, At, B1); PG8_BAR;
        }
        E(acc, cur, wr, wc, fr, fq);
        if (!has_next) break;
#pragma unroll
        for (int a = 0; a < 2; ++a)
#pragma unroll
            for (int b = 0; b < 2; ++b)
#pragma unroll
                for (int m = 0; m < 4; ++m)
#pragma unroll
                    for (int n = 0; n < 2; ++n) acc[a][b][m][n] = (f32x4){0.f, 0.f, 0.f, 0.f};
        cur = nxt; cA = nA; cB = nB; ++ui;
    }
    PG8_WAIT_V(0);
    if (wr == 0) PG8_BAR;
    PG8_BAR;
#undef PG8_SA
#undef PG8_SB
#undef PG8_STAGE
#undef PG8_LDA
#undef PG8_LDB
#undef PG8_MMA
#undef PG8_WAIT_V
#undef PG8_WAIT_L
#undef PG8_BAR
#undef PG8_SCHED
}
}
using pg8::Unit;

struct EpiSwiglu {
    static constexpr bool PERM = true;
    unsigned char* act;
    __device__ __forceinline__ void operator()(const f32x4 (&acc)[2][2][4][2], const Unit& u, int wr, int wc, int fr, int fq) const {
        const int row0 = u.pm * 256 + wr * 64 + fr, col0 = u.pn * 128 + wc * 32 + 8 * fq;
        constexpr float inv = 1.f / (SC_H * SC_WGU), osc = SC_ACT * inv;
#pragma unroll
        for (int ai = 0; ai < 2; ++ai)
#pragma unroll
            for (int m = 0; m < 4; ++m) {
                const f32x4 g0 = acc[ai][0][m][0] * inv, g1 = acc[ai][0][m][1] * inv, u0 = acc[ai][1][m][0] * osc, u1 = acc[ai][1][m][1] * osc;
                u32x2 w;
                w.x = pk_fp8x4(siluf(g0[0]) * u0[0], siluf(g0[1]) * u0[1], siluf(g0[2]) * u0[2], siluf(g0[3]) * u0[3]);
                w.y = pk_fp8x4(siluf(g1[0]) * u1[0], siluf(g1[1]) * u1[1], siluf(g1[2]) * u1[2], siluf(g1[3]) * u1[3]);
                *(u32x2*)(act + (size_t)(row0 + ai * 128 + m * 16) * DFF + col0) = w;
            }
    }
};
struct EpiPart {
    static constexpr bool PERM = true;
    bf16_t* part; float sc;
    __device__ __forceinline__ void operator()(const f32x4 (&acc)[2][2][4][2], const Unit& u, int wr, int wc, int fr, int fq) const {
        bf16_t* dst = part + (size_t)u.s * MP * 1024;
        const int row0 = u.pm * 256 + wr * 64 + fr, col0 = u.pn * 256 + wc * 32 + 8 * fq;
#pragma unroll
        for (int ai = 0; ai < 2; ++ai)
#pragma unroll
            for (int m = 0; m < 4; ++m) { bf16_t* rowp = dst + (size_t)(row0 + ai * 128 + m * 16) * 1024 + col0;
#pragma unroll
                for (int bj = 0; bj < 2; ++bj) { const f32x4 v0 = acc[ai][bj][m][0] * sc, v1 = acc[ai][bj][m][1] * sc;
                    u32x4 w; w.x = cvt_pk_bf16(v0[0], v0[1]); w.y = cvt_pk_bf16(v0[2], v0[3]); w.z = cvt_pk_bf16(v1[0], v1[1]); w.w = cvt_pk_bf16(v1[2], v1[3]);
                    *(u32x4*)(rowp + bj * 128) = w; if (u.full) *(u32x4*)(rowp + (size_t)MP * 1024 + bj * 128) = (u32x4){0u, 0u, 0u, 0u}; } }
    }
};
template <int KIND> struct EpiProj {
    static constexpr bool PERM = true;
    unsigned char* proj; const float* ropec; const float* ropes; const float* lbp;
    __device__ __forceinline__ void operator()(const f32x4 (&acc)[2][2][4][2], const Unit& u, int wr, int wc, int fr, int fq) const {
        int type, ld, col0; unsigned char* base; float rscale = 1.f;
        const int pn = u.pn;
        if (KIND == 0) {
            const int seg = pn >> 2; col0 = (pn & 3) * 256; ld = 1024;
            if (seg == 0) { type = 1; base = proj; }
            else if (seg == 1) { type = 4; base = proj + (size_t)MP * 2048; }
            else if (seg == 2) { type = 0; base = proj + (size_t)MP * 6144; }
            else { type = 1; base = proj + (size_t)MP * 8192; }
        } else if (KIND == 1) {
            if (pn < 4) { type = 3; base = proj; ld = 1024; col0 = pn * 256; }
            else if (pn < 8) { type = 3; base = proj + (size_t)MP * 2048; ld = 1024; col0 = (pn - 4) * 256; rscale = 0.0625f; }
            else if (pn < 16) { type = 0; base = proj + (size_t)MP * 4096; ld = 2048; col0 = (pn - 8) * 256; }
            else { type = 1; base = proj + (size_t)MP * 8192; ld = 2048; col0 = (pn - 16) * 256; }
        } else {
            if (pn < 8) { type = 1; base = proj; ld = 2048; col0 = pn * 256; }
            else if (pn < 24) { type = 0; base = proj + (size_t)MP * 4096; ld = 4096; col0 = (pn - 8) * 256; }
            else { type = 2; base = proj + (size_t)MP * 12288; ld = 256; col0 = 0; }
        }
        const int row0 = u.pm * 256 + wr * 64 + fr, cl = wc * 32 + 8 * fq;
#pragma unroll
        for (int ai = 0; ai < 2; ++ai)
#pragma unroll
            for (int m = 0; m < 4; ++m) {
                const int row = row0 + ai * 128 + m * 16;
                if (type == 2) {
                    float* rp = (float*)base + (size_t)row * ld + col0 + cl;
#pragma unroll
                    for (int bj = 0; bj < 2; ++bj)
#pragma unroll
                        for (int n = 0; n < 2; ++n) *(f32x4*)(rp + bj * 128 + 4 * n) = acc[ai][bj][m][n];
                } else if (type == 4) {
                    float* rp = (float*)base + (size_t)row * ld + col0 + cl; bf16_t* kp = (bf16_t*)(proj + (size_t)MP * 10240) + (size_t)row * ld + col0 + cl;
#pragma unroll
                    for (int bj = 0; bj < 2; ++bj) { f32x4 lfv[2], kkv[2];
#pragma unroll
                        for (int n = 0; n < 2; ++n) { const f32x4 lbq = *(const f32x4*)(lbp + col0 + cl + bj * 128 + 4 * n);
#pragma unroll
                            for (int e = 0; e < 4; ++e) { const float z = fminf(fmaxf(acc[ai][bj][m][n][e], -30.f), 30.f); const float sg = __builtin_amdgcn_rcpf(1.f + __expf(-z)); const float oml = 1.f - lbq[e];
                                lfv[n][e] = __logf(lbq[e] + oml * sg); kkv[n][e] = oml * (1.f - sg); }
                            *(f32x4*)(rp + bj * 128 + 4 * n) = lfv[n]; }
                        u32x4 w; w.x = cvt_pk_bf16(kkv[0][0], kkv[0][1]); w.y = cvt_pk_bf16(kkv[0][2], kkv[0][3]); w.z = cvt_pk_bf16(kkv[1][0], kkv[1][1]); w.w = cvt_pk_bf16(kkv[1][2], kkv[1][3]);
                        *(u32x4*)(kp + bj * 128) = w; }
                } else if (type == 3) {
                    const int pi = pos_index(row);
                    const f32x4 c0 = *(const f32x4*)(ropec + pi * 128 + cl), c1 = *(const f32x4*)(ropec + pi * 128 + cl + 4);
                    const f32x4 s0 = *(const f32x4*)(ropes + pi * 128 + cl), s1 = *(const f32x4*)(ropes + pi * 128 + cl + 4);
                    const f32x4 x10 = acc[ai][0][m][0], x11 = acc[ai][0][m][1], x20 = acc[ai][1][m][0], x21 = acc[ai][1][m][1];
                    const f32x4 a0 = (x10 * c0 - x20 * s0) * rscale, a1 = (x11 * c1 - x21 * s1) * rscale;
                    const f32x4 b0 = (x10 * s0 + x20 * c0) * rscale, b1 = (x11 * s1 + x21 * c1) * rscale;
                    bf16_t* rp = (bf16_t*)base + (size_t)row * ld + col0 + cl;
                    u32x4 w; w.x = cvt_pk_bf16(a0[0], a0[1]); w.y = cvt_pk_bf16(a0[2], a0[3]); w.z = cvt_pk_bf16(a1[0], a1[1]); w.w = cvt_pk_bf16(a1[2], a1[3]);
                    *(u32x4*)rp = w;
                    w.x = cvt_pk_bf16(b0[0], b0[1]); w.y = cvt_pk_bf16(b0[2], b0[3]); w.z = cvt_pk_bf16(b1[0], b1[1]); w.w = cvt_pk_bf16(b1[2], b1[3]);
                    *(u32x4*)(rp + 128) = w;
                } else {
                    bf16_t* rp = (bf16_t*)base + (size_t)row * ld + col0 + cl;
#pragma unroll
                    for (int bj = 0; bj < 2; ++bj) {
                        f32x4 v0 = acc[ai][bj][m][0], v1 = acc[ai][bj][m][1];
                        if (type == 1) {
#pragma unroll
                            for (int e = 0; e < 4; ++e) { v0[e] = siluf(v0[e]); v1[e] = siluf(v1[e]); }
                        }
                        u32x4 w; w.x = cvt_pk_bf16(v0[0], v0[1]); w.y = cvt_pk_bf16(v0[2], v0[3]); w.z = cvt_pk_bf16(v1[0], v1[1]); w.w = cvt_pk_bf16(v1[2], v1[3]);
                        *(u32x4*)(rp + bj * 128) = w;
                    }
                }
            }
    }
};

struct XJob { const float* src; bf16_t* dst; int K, N, grp, gstride, goff; float f8scale; };
__device__ __forceinline__ XJob xpose_job(ArgsP a_, int job) { const ArgsP a = a_;
    XJob j; j.grp = 1 << 30; j.gstride = 0; j.goff = 0; j.f8scale = 0.f;
    if (job < 16) { const int idx = job & 7; j.src = (job < 8 ? AIN(9) : AIN(10)) + (size_t)idx * 1024 * DFF; j.K = 1024; j.N = DFF;
        j.dst = (bf16_t*)(a->ws + W_GU + (size_t)idx * 5632 * 1024); j.grp = 128; j.gstride = 256; j.goff = job < 8 ? 0 : 128; j.f8scale = SC_WGU; }
    else if (job < 24) { const int idx = job - 16; j.src = AIN(11) + (size_t)idx * DFF * 1024; j.K = DFF; j.N = 1024; j.dst = (bf16_t*)(a->ws + W_D + (size_t)idx * 1024 * DFF); j.f8scale = SC_WD; }
    else if (job < 26) { const int idx = job - 24; j.src = AIN(13) + (size_t)idx * 1024 * 4096; j.K = 1024; j.N = 4096; j.dst = (bf16_t*)(a->ws + W_HGI) + (size_t)idx * 4096 * 1024; }
    else if (job < 28) { const int idx = job - 26; j.src = AIN(15) + (size_t)idx * 1024 * 1024; j.K = 1024; j.N = 1024; j.dst = (bf16_t*)(a->ws + W_HGO) + (size_t)idx * 1024 * 1024; }
    else if (job == 28) { j.src = AIN(16); j.K = 1024; j.N = 6144; j.dst = (bf16_t*)(a->ws + W_RI); }
    else if (job == 29) { j.src = AIN(18); j.K = 2048; j.N = 1024; j.dst = (bf16_t*)(a->ws + W_RO); }
    else if (job == 30) { j.src = AIN(19); j.K = 1024; j.N = 6176; j.dst = (bf16_t*)(a->ws + W_MI); }
    else { j.src = AIN(26); j.K = 2048; j.N = 1024; j.dst = (bf16_t*)(a->ws + W_MO); }
    return j;
}

template <bool F8>
__device__ __forceinline__ void xpose_run(ArgsP a_, unsigned char* smem, int c, int G) { const ArgsP a = a_;
    const int tid = TID();
    float* tile = (float*)smem;
    int base = 0;
    for (int job = 0; job < 32; ++job) {
        if ((job < 24) != F8) continue;
        const XJob j = xpose_job(a, job);
        const int nk = j.K / 64, nn = (j.N + 255) / 256, ntile = nk * nn;
        const int off = (int)(((long)c - base % G + G) % G);
        for (int t = off; t < ntile; t += G) {
            const int k0 = (t % nk) * 64, n0 = (t / nk) * 256;
            { const int n4 = (tid & 63) * 4, ks = tid >> 6;
              f32x4 v[8];
#pragma unroll
              for (int it = 0; it < 8; ++it) { const int k = ks + 8 * it; v[it] = (n0 + n4 < j.N) ? *(const f32x4*)(j.src + (size_t)(k0 + k) * j.N + n0 + n4) : (f32x4){0.f, 0.f, 0.f, 0.f}; }
#pragma unroll
              for (int it = 0; it < 8; ++it) { const int k = ks + 8 * it; float* tp = tile + k * 257 + n4; tp[0] = v[it][0]; tp[1] = v[it][1]; tp[2] = v[it][2]; tp[3] = v[it][3]; } }
            __syncthreads();
            { const int kk = tid & 7, nq = tid >> 3;
#pragma unroll
              for (int it = 0; it < 4; ++it) { const int n = nq + 64 * it; const int ng = n0 + n;
                  if (ng < j.N) { const int dr = (ng / j.grp) * j.gstride + j.goff + ng % j.grp; const float* tp = tile + (8 * kk) * 257 + n;
                      const float x0 = tp[0], x1 = tp[257], x2 = tp[2 * 257], x3 = tp[3 * 257], x4 = tp[4 * 257], x5 = tp[5 * 257], x6 = tp[6 * 257], x7 = tp[7 * 257];
                      if (F8) { const float fs = j.f8scale; *(u32x2*)((unsigned char*)j.dst + (size_t)dr * j.K + k0 + 8 * kk) = (u32x2){pk_fp8x4(x0 * fs, x1 * fs, x2 * fs, x3 * fs), pk_fp8x4(x4 * fs, x5 * fs, x6 * fs, x7 * fs)}; }
                      else *(u32x4*)(j.dst + (size_t)dr * j.K + k0 + 8 * kk) = (u32x4){cvt_pk_bf16(x0, x1), cvt_pk_bf16(x2, x3), cvt_pk_bf16(x4, x5), cvt_pk_bf16(x6, x7)}; } } }
            __syncthreads();
        }
        base += ntile;
    }
}

__device__ __forceinline__ void setup_phase(ArgsP a_, unsigned char* smem) { const ArgsP a = a_;
    const int tid = TID(), G = gridDim.x, c = BID();
    xpose_run<true>(a, smem, c, G); xpose_run<false>(a, smem, c, G);
    const size_t gt = (size_t)c * 512 + tid, gs = (size_t)G * 512;
    { unsigned* z = (unsigned*)((bf16_t*)(a->ws + W_MI) + (size_t)6176 * 1024); for (size_t i = gt; i < 224ull * 1024 / 2; i += gs) z[i] = 0u; }
    { bf16_t* HB = (bf16_t*)(a->ws + B_HB);
      for (size_t i = gt; i < (size_t)M_ * 256; i += gs) { const int row = (int)(i >> 8), c4 = (int)(i & 255) * 4; const float* src;
          if (row < RP) { const int b = row / TP, t = row % TP; src = t < 16 ? AIN(6) + (size_t)t * 1024 : AIN(0) + ((size_t)b * 2048 + t - 16) * 1024; }
          else src = AIN(1) + (size_t)(row - RP) * 1024;
          const f32x4 v = *(const f32x4*)(src + c4);
          u32x2 w; w.x = cvt_pk_bf16(v[0], v[1]); w.y = cvt_pk_bf16(v[2], v[3]); *(u32x2*)(HB + (size_t)row * 1024 + c4) = w;
          *(unsigned*)(a->ws + B_HB8 + (size_t)row * 1024 + c4) = pk_fp8x4(v[0] * SC_H, v[1] * SC_H, v[2] * SC_H, v[3] * SC_H); } }
    { float* rc = (float*)(a->ws + B_ROPE); float* rs = rc + NPOS * 128;
      for (size_t i = gt; i < (size_t)NPOS * 128; i += gs) { const int p = (int)(i >> 7), jf = (int)(i & 127); const int pos = p < TP ? p : 16384 + (p - TP);
          double f = 1.0, r = 0.930572040929699; int e = jf; while (e) { if (e & 1) f *= r; r *= r; e >>= 1; }
          double rev = (double)pos * f * 0.15915494309189535; rev -= floor(rev); const float fr_ = (float)rev;
          rc[i] = __builtin_amdgcn_cosf(fr_); rs[i] = __builtin_amdgcn_sinf(fr_); } }
    { float* LB = (float*)(a->ws + B_LB); const float* lg = AIN(12);
      for (size_t i = gt; i < 1024; i += gs) { const float l0 = lg[i], l1 = lg[1024 + i], l2 = lg[2048 + i], l3 = lg[3072 + i]; const float mx = fmaxf(fmaxf(l0, l1), fmaxf(l2, l3));
          const float e0 = __expf(l0 - mx), e1 = __expf(l1 - mx), e2 = __expf(l2 - mx), e3 = __expf(l3 - mx); LB[i] = 0.f; LB[1024 + i] = (e1 + e2 + e3) / (e0 + e1 + e2 + e3); } }
}

__device__ __forceinline__ void ln_phase(ArgsP a_, int lnidx, float cs, bool final_) { const ArgsP a = a_;
    const int lane = TID() & 63, wv = TID() >> 6; const int gw = BID() * 8 + wv, nw = gridDim.x * 8;
    bf16_t* HB = (bf16_t*)(a->ws + B_HB); const bf16_t* P0 = (const bf16_t*)(a->ws + B_PARTB); const bf16_t* P1 = P0 + (size_t)MP * 1024;
    const float* g = AIN(7) + (size_t)lnidx * 1024; const float* bb = AIN(8) + (size_t)lnidx * 1024;
    const bool xa = gridDim.x == 256; const int xb0 = (BID() & 7) * (M_ / 8);
    const int row_lo = xa ? xb0 + (BID() >> 3) * 8 + wv : gw, row_hi = xa ? xb0 + M_ / 8 : M_, row_st = xa ? 256 : nw;
    for (int row = row_lo; row < row_hi; row += row_st) {
        float z[16]; float s = 0.f;
#pragma unroll
        for (int q = 0; q < 2; ++q) { const size_t o = (size_t)row * 1024 + q * 512 + lane * 8; const u32x4 h = *(const u32x4*)(HB + o), p0 = *(const u32x4*)(P0 + o), p1 = *(const u32x4*)(P1 + o);
#pragma unroll
            for (int e = 0; e < 4; ++e) { const unsigned hh = h[e], a0 = p0[e], a1 = p1[e];
                z[q * 8 + 2 * e] = __uint_as_float(hh << 16) * ALPHA + (__uint_as_float(a0 << 16) + __uint_as_float(a1 << 16)) * cs;
                z[q * 8 + 2 * e + 1] = __uint_as_float(hh & 0xffff0000u) * ALPHA + (__uint_as_float(a0 & 0xffff0000u) + __uint_as_float(a1 & 0xffff0000u)) * cs; } }
#pragma unroll
        for (int e = 0; e < 16; ++e) s += z[e];
        const float mean = wave_sum(s) * (1.f / 1024.f); float v = 0.f;
#pragma unroll
        for (int e = 0; e < 16; ++e) { const float d = z[e] - mean; v += d * d; }
        const float rstd = rsqrtf(wave_sum(v) * (1.f / 1024.f) + LN_EPS);
        float* yo = nullptr;
        if (final_) { if (row < RP) { const int b = row / TP, t = row % TP; if (t >= 16) yo = a->out + O_YP + ((size_t)b * 2048 + t - 16) * 1024; } else yo = a->out + O_YS + (size_t)(row - RP) * 1024; }
#pragma unroll
        for (int q = 0; q < 2; ++q) { const int cc = q * 512 + lane * 8; const f32x4 g0 = *(const f32x4*)(g + cc), g1 = *(const f32x4*)(g + cc + 4), b0 = *(const f32x4*)(bb + cc), b1 = *(const f32x4*)(bb + cc + 4);
            f32x4 o0, o1;
#pragma unroll
            for (int e = 0; e < 4; ++e) { o0[e] = (z[q * 8 + e] - mean) * rstd * g0[e] + b0[e]; o1[e] = (z[q * 8 + 4 + e] - mean) * rstd * g1[e] + b1[e]; }
            if (final_) { if (yo) { *(f32x4*)(yo + cc) = o0; *(f32x4*)(yo + cc + 4) = o1; } }
            else { *(u32x4*)(HB + (size_t)row * 1024 + cc) = (u32x4){cvt_pk_bf16(o0[0], o0[1]), cvt_pk_bf16(o0[2], o0[3]), cvt_pk_bf16(o1[0], o1[1]), cvt_pk_bf16(o1[2], o1[3])};
                   *(u32x2*)(a->ws + B_HB8 + (size_t)row * 1024 + cc) = (u32x2){pk_fp8x4(o0[0] * SC_H, o0[1] * SC_H, o0[2] * SC_H, o0[3] * SC_H), pk_fp8x4(o1[0] * SC_H, o1[1] * SC_H, o1[2] * SC_H, o1[3] * SC_H)}; } }
    }
}

template <int DK, int DV, bool SEPQ>
__device__ __forceinline__ void scan_core(const bf16_t* QA, const bf16_t* KB, const bf16_t* QS, const bf16_t* KT, const bf16_t* VT, const bf16_t* VT2,
                                          bf16_t* ST, bf16_t* P, const float* GI, const float* SDEC,
                                          f32x4 (&S)[DK / 128][DV / 16], f32x4 (&O)[DV / 32], int wid, int fr, int fq) {
    constexpr int LQ = DK + 8, LJ = 72, NCTW = DK / 128, NVT = DV / 16, NVTW = NVT / 2;
    const int m = wid >> 1, hw = wid & 1;
#pragma unroll
    for (int ct = 0; ct < NCTW; ++ct)
#pragma unroll
        for (int vt = 0; vt < NVT; ++vt) { const f32x4 s = S[ct][vt]; u32x2 w; w.x = cvt_pk_bf16(s[0], s[1]); w.y = cvt_pk_bf16(s[2], s[3]);
            *(u32x2*)(ST + (16 * vt + fr) * LQ + 16 * (wid * NCTW + ct) + 4 * fq) = w; }
    __syncthreads();
    {
        const float gi_i = GI[16 * m + fr];
        const int n0 = 2 * hw, n1 = 2 * hw + 1; const bool do0 = n0 <= m, do1 = n1 <= m;
        f32x4 acc0 = {0.f, 0.f, 0.f, 0.f}, acc1 = {0.f, 0.f, 0.f, 0.f};
#pragma unroll
        for (int vt = 0; vt < NVTW; ++vt) O[vt] = (f32x4){0.f, 0.f, 0.f, 0.f};
#pragma unroll
        for (int ks = 0; ks < DK / 32; ++ks) {
            const bf16x8 qf = *(const bf16x8*)(QA + (16 * m + fr) * LQ + 32 * ks + 8 * fq);
            if (do0) { const bf16x8 kf = *(const bf16x8*)(KB + (16 * n0 + fr) * LQ + 32 * ks + 8 * fq); acc0 = __builtin_amdgcn_mfma_f32_16x16x32_bf16(kf, qf, acc0, 0, 0, 0); }
            if (do1) { const bf16x8 kf = *(const bf16x8*)(KB + (16 * n1 + fr) * LQ + 32 * ks + 8 * fq); acc1 = __builtin_amdgcn_mfma_f32_16x16x32_bf16(kf, qf, acc1, 0, 0, 0); }
            bf16x8 qs = qf; if (SEPQ) qs = *(const bf16x8*)(QS + (16 * m + fr) * LQ + 32 * ks + 8 * fq);
#pragma unroll
            for (int vt = 0; vt < NVTW; ++vt) { const bf16x8 sf = *(const bf16x8*)(ST + (16 * (hw * NVTW + vt) + fr) * LQ + 32 * ks + 8 * fq); O[vt] = __builtin_amdgcn_mfma_f32_16x16x32_bf16(sf, qs, O[vt], 0, 0, 0); }
        }
#pragma unroll
        for (int nn = 0; nn < 2; ++nn) {
            const int n = 2 * hw + nn; const f32x4 acc = nn == 0 ? acc0 : acc1;
            const f32x4 gj = *(const f32x4*)(GI + 16 * n + 4 * fq); const int i = 16 * m + fr, j0 = 16 * n + 4 * fq; float p[4];
#pragma unroll
            for (int e = 0; e < 4; ++e) p[e] = (j0 + e <= i) ? acc[e] * __expf(gi_i - gj[e]) : 0.f;
            u32x2 w; w.x = cvt_pk_bf16(p[0], p[1]); w.y = cvt_pk_bf16(p[2], p[3]); *(u32x2*)(P + (16 * m + fr) * LJ + j0) = w;
        }
        const float ei = __expf(gi_i);
#pragma unroll
        for (int vt = 0; vt < NVTW; ++vt) O[vt] = O[vt] * ei;
    }
    __syncthreads();
#pragma unroll
    for (int ks = 0; ks < 2; ++ks) { const bf16x8 pf = *(const bf16x8*)(P + (16 * m + fr) * LJ + 32 * ks + 8 * fq);
#pragma unroll
        for (int vt = 0; vt < NVTW; ++vt) { const bf16x8 vf = *(const bf16x8*)(VT + (16 * (hw * NVTW + vt) + fr) * LJ + 32 * ks + 8 * fq); O[vt] = __builtin_amdgcn_mfma_f32_16x16x32_bf16(vf, pf, O[vt], 0, 0, 0); } }
#pragma unroll
    for (int ct = 0; ct < NCTW; ++ct) { const int ctg = wid * NCTW + ct; const f32x4 dec = *(const f32x4*)(SDEC + 16 * ctg + 4 * fq);
#pragma unroll
        for (int vt = 0; vt < NVT; ++vt) S[ct][vt] = S[ct][vt] * dec;
#pragma unroll
        for (int ks = 0; ks < 2; ++ks) { const bf16x8 kf = *(const bf16x8*)(KT + (16 * ctg + fr) * LJ + 32 * ks + 8 * fq);
#pragma unroll
            for (int vt = 0; vt < NVT; ++vt) { const bf16x8 vf = *(const bf16x8*)(VT2 + (16 * vt + fr) * LJ + 32 * ks + 8 * fq); S[ct][vt] = __builtin_amdgcn_mfma_f32_16x16x32_bf16(kf, vf, S[ct][vt], 0, 0, 0); } } }
}

template <int DK, int DV>
__device__ __forceinline__ void state_load(f32x4 (&S)[DK / 128][DV / 16], const float* src, int ldv, int wid, int fr, int fq, bool zero) {
#pragma unroll
    for (int ct = 0; ct < DK / 128; ++ct)
#pragma unroll
        for (int vt = 0; vt < DV / 16; ++vt) {
            if (zero) S[ct][vt] = (f32x4){0.f, 0.f, 0.f, 0.f};
            else { const float* p = src + (size_t)(16 * (wid * (DK / 128) + ct) + 4 * fq) * ldv + 16 * vt + fr; S[ct][vt] = (f32x4){p[0], p[ldv], p[2 * ldv], p[3 * ldv]}; }
        }
}
template <int DK, int DV>
__device__ __forceinline__ void state_store(const f32x4 (&S)[DK / 128][DV / 16], float* dst, int ldv, int wid, int fr, int fq) {
#pragma unroll
    for (int ct = 0; ct < DK / 128; ++ct)
#pragma unroll
        for (int vt = 0; vt < DV / 16; ++vt) { float* p = dst + (size_t)(16 * (wid * (DK / 128) + ct) + 4 * fq) * ldv + 16 * vt + fr;
            p[0] = S[ct][vt][0]; p[ldv] = S[ct][vt][1]; p[2 * ldv] = S[ct][vt][2]; p[3 * ldv] = S[ct][vt][3]; }
}

__device__ __forceinline__ void hg_block(ArgsP a_, int jl, unsigned char* smem) { const ArgsP a = a_;
    constexpr int LQ = 136, LJ = 72;
    bf16_t* QA = (bf16_t*)smem; bf16_t* KB = (bf16_t*)(smem + 17408); bf16_t* QS = (bf16_t*)(smem + 34816); bf16_t* KT = (bf16_t*)(smem + 52224); bf16_t* VT = (bf16_t*)(smem + 70656);
    bf16_t* ST = (bf16_t*)(smem + 89088); bf16_t* P = (bf16_t*)(smem + 123904); float* GI = (float*)(smem + 133120); float* SDEC = (float*)(smem + 133376);
    float* TOT = (float*)(smem + 133888);   float* RSm = (float*)(smem + 142080);
    const int tid = TID(), wid = tid >> 6, lane = tid & 63, fr = lane & 15, fq = lane >> 4;
    const int G = gridDim.x, cb = BID();
    const unsigned char* proj = a->ws + B_PROJ;
    const bf16_t* Qg = (const bf16_t*)proj; const float* LFg = (const float*)(proj + (size_t)MP * 2048); const bf16_t* Vg = (const bf16_t*)(proj + (size_t)MP * 6144); const bf16_t* Gg = (const bf16_t*)(proj + (size_t)MP * 8192);
    const bf16_t* KKg = (const bf16_t*)(proj + (size_t)MP * 10240);
    bf16_t* ON = (bf16_t*)(a->ws + B_ACT);
    const float* ng = AIN(14) + (size_t)jl * 1024;
    const int nunits = cb < 64 ? 33 : (1024 - (cb - 64) + (G - 64) - 1) / (G - 64);
    const int c4 = (tid & 31) * 4, rg = tid >> 5, m = wid >> 1, hw = wid & 1, irow = 16 * m + fr;
    f32x4 S[1][8]; f32x4 O[4];
    f32x4 lf4[4]; u32x2 kk2[4], q2[4], v2[4]; u32x2 gpre[4];
    if (tid < 64) GI[tid] = 0.f;
#define HG_DECODE(u, b_, h_, ck_, smp_, row0_, len_) do { if (cb < 64) { b_ = cb >> 3; h_ = cb & 7; ck_ = (u); smp_ = false; row0_ = b_ * TP + 64 * ck_; len_ = ck_ < 32 ? 64 : 16; } \
        else { const int it_ = (cb - 64) + (u) * (G - 64); b_ = it_ >> 3; h_ = it_ & 7; ck_ = 0; smp_ = true; row0_ = RP + 8 * b_; len_ = 8; } } while (0)
#define HG_LOAD(u) do { int b_, h_, ck_, row0_, len_; bool smp_; HG_DECODE(u, b_, h_, ck_, smp_, row0_, len_); \
        _Pragma("unroll") for (int r = 0; r < 4; ++r) { const int i = 4 * rg + r; const size_t o = (size_t)(row0_ + i) * 1024 + h_ * 128 + c4; const bool valid = i < len_; \
            const f32x4 l_ = *(const f32x4*)(LFg + o); const u32x2 k_ = *(const u32x2*)(KKg + o), q_ = *(const u32x2*)(Qg + o), v_ = *(const u32x2*)(Vg + o); const u32x2 z2 = {0u, 0u}; const f32x4 z4 = {0.f, 0.f, 0.f, 0.f}; \
            lf4[r] = valid ? l_ : z4; kk2[r] = valid ? k_ : z2; q2[r] = valid ? q_ : z2; v2[r] = valid ? v_ : z2; } \
        _Pragma("unroll") for (int vt = 0; vt < 4; ++vt) gpre[vt] = *(const u32x2*)(Gg + (size_t)(row0_ + irow) * 1024 + h_ * 128 + 16 * (hw * 4 + vt) + 4 * fq); } while (0)
    if (nunits > 0) HG_LOAD(0);
    const int ntot_ = cb < 64 ? nunits : nunits * REP_SMP;
    for (int uu = 0; uu < ntot_; ++uu) { const int u = cb < 64 ? uu : uu % nunits; const int un_ = cb < 64 ? uu + 1 : (uu + 1) % nunits;
        int b, h, ck, row0, len; bool sample; HG_DECODE(u, b, h, ck, sample, row0, len);
        const bool first = sample || ck == 0, last = sample || ck == 32;
        if (first) state_load<128, 128>(S, AIN(2) + (((size_t)jl * 128 + b) * 8 + h) * 16384, 128, wid, fr, fq, !sample);
        f32x4 cs[4];
        { f32x4 run = {0.f, 0.f, 0.f, 0.f};
#pragma unroll
          for (int r = 0; r < 4; ++r) { run = run + lf4[r]; cs[r] = run; }
          *(f32x4*)(TOT + rg * 128 + c4) = run; }
        __syncthreads();
        { f32x4 pre = {0.f, 0.f, 0.f, 0.f}, gmid = pre, glast = pre;
#pragma unroll
          for (int k = 0; k < 16; ++k) { const f32x4 t = *(const f32x4*)(TOT + k * 128 + c4); if (k < rg) pre = pre + t; if (k < 8) gmid = gmid + t; glast = glast + t; }
          f32x4 Emid, Elm;
#pragma unroll
          for (int e = 0; e < 4; ++e) { Emid[e] = __expf(gmid[e]); Elm[e] = __expf(glast[e] - gmid[e]); }
          float ktv[4][4];
#pragma unroll
          for (int r = 0; r < 4; ++r) { const int i = 4 * rg + r; const f32x4 d = pre + cs[r] - gmid;
              const f32x4 q = {__uint_as_float(q2[r].x << 16), __uint_as_float(q2[r].x & 0xffff0000u), __uint_as_float(q2[r].y << 16), __uint_as_float(q2[r].y & 0xffff0000u)};
              const f32x4 kk = {__uint_as_float(kk2[r].x << 16), __uint_as_float(kk2[r].x & 0xffff0000u), __uint_as_float(kk2[r].y << 16), __uint_as_float(kk2[r].y & 0xffff0000u)};
              f32x4 qa, qs, kb;
#pragma unroll
              for (int e = 0; e < 4; ++e) { const float eq = __expf(d[e]), ek = __expf(-d[e]); qa[e] = q[e] * eq; qs[e] = qa[e] * Emid[e]; kb[e] = kk[e] * ek; ktv[r][e] = kb[e] * Elm[e]; }
              *(u32x2*)(QA + i * LQ + c4) = (u32x2){cvt_pk_bf16(qa[0], qa[1]), cvt_pk_bf16(qa[2], qa[3])};
              *(u32x2*)(QS + i * LQ + c4) = (u32x2){cvt_pk_bf16(qs[0], qs[1]), cvt_pk_bf16(qs[2], qs[3])};
              *(u32x2*)(KB + i * LQ + c4) = (u32x2){cvt_pk_bf16(kb[0], kb[1]), cvt_pk_bf16(kb[2], kb[3])}; }
#pragma unroll
          for (int e = 0; e < 4; ++e) {
              *(u32x2*)(KT + (c4 + e) * LJ + 4 * rg) = (u32x2){cvt_pk_bf16(ktv[0][e], ktv[1][e]), cvt_pk_bf16(ktv[2][e], ktv[3][e])};
              unsigned vv[4];
#pragma unroll
              for (int r = 0; r < 4; ++r) { const unsigned w = (e < 2) ? v2[r].x : v2[r].y; vv[r] = (e & 1) ? (w >> 16) : (w & 0xffffu); }
              *(u32x2*)(VT + (c4 + e) * LJ + 4 * rg) = (u32x2){vv[0] | (vv[1] << 16), vv[2] | (vv[3] << 16)}; }
          if (rg == 0) { f32x4 sd;
#pragma unroll
              for (int e = 0; e < 4; ++e) sd[e] = __expf(glast[e]);
              *(f32x4*)(SDEC + c4) = sd; } }
        u32x2 gcur[4];
#pragma unroll
        for (int vt = 0; vt < 4; ++vt) gcur[vt] = gpre[vt];
        if (uu + 1 < ntot_) HG_LOAD(un_);
        scan_core<128, 128, true>(QA, KB, QS, KT, VT, VT, ST, P, GI, SDEC, S, O, wid, fr, fq);
        { float ss = 0.f;
#pragma unroll
          for (int vt = 0; vt < 4; ++vt) ss += (O[vt][0] * O[vt][0] + O[vt][1] * O[vt][1]) + (O[vt][2] * O[vt][2] + O[vt][3] * O[vt][3]);
          ss += __shfl_xor(ss, 16); ss += __shfl_xor(ss, 32); if (fq == 0) RSm[irow * 2 + hw] = ss; }
        __syncthreads();
        if (irow < len) { const float rstd = rsqrtf((RSm[irow * 2] + RSm[irow * 2 + 1]) * (1.f / 128.f) + LN_EPS);
#pragma unroll
            for (int vt = 0; vt < 4; ++vt) { const int v = 16 * (hw * 4 + vt) + 4 * fq; const size_t o = (size_t)(row0 + irow) * 1024 + h * 128 + v;
                const f32x4 gg = *(const f32x4*)(ng + h * 128 + v); const u32x2 gt = gcur[vt];
                const float g0 = __uint_as_float(gt.x << 16), g1 = __uint_as_float(gt.x & 0xffff0000u), g2 = __uint_as_float(gt.y << 16), g3 = __uint_as_float(gt.y & 0xffff0000u);
                u32x2 w; w.x = cvt_pk_bf16(O[vt][0] * rstd * gg[0] * g0, O[vt][1] * rstd * gg[1] * g1); w.y = cvt_pk_bf16(O[vt][2] * rstd * gg[2] * g2, O[vt][3] * rstd * gg[3] * g3);
                *(u32x2*)(ON + o) = w; } }
        if (last) { float* dst = a->out + (sample ? O_HGS : O_HGP) + (((size_t)jl * (sample ? 128 : 8) + b) * 8 + h) * 16384; state_store<128, 128>(S, dst, 128, wid, fr, fq); }
    }
#undef HG_DECODE
#undef HG_LOAD
    __syncthreads();
}

__device__ __forceinline__ void ret_block(ArgsP a_, unsigned char* smem) { const ArgsP a = a_;
    constexpr int LQ = 264, LJ = 72;
    bf16_t* QA = (bf16_t*)smem; bf16_t* KB = (bf16_t*)(smem + 33792); bf16_t* KT = (bf16_t*)(smem + 67584); bf16_t* VT = (bf16_t*)(smem + 104448);
    bf16_t* ST = (bf16_t*)(smem + 113664); bf16_t* P = (bf16_t*)(smem + 147456); float* GI = (float*)(smem + 156672); float* SDEC = (float*)(smem + 156928); float* DECJ = (float*)(smem + 157952);
    const int tid = TID(), wid = tid >> 6, lane = tid & 63, fr = lane & 15, fq = lane >> 4;
    const int G = gridDim.x, cb0 = BID();
    const int cb = (G == 256) ? ((((cb0 & 7) * 4 + (cb0 >> 6)) << 3) | ((cb0 >> 3) & 7)) : cb0;
    const unsigned char* proj = a->ws + B_PROJ;
    const bf16_t* Qg = (const bf16_t*)proj; const bf16_t* Kg = (const bf16_t*)(proj + (size_t)MP * 2048); const bf16_t* Vg = (const bf16_t*)(proj + (size_t)MP * 4096);
    bf16_t* OB = (bf16_t*)(a->ws + B_PART);
    const int np = cb < 256 ? 33 : 0;
    const int s0 = cb < 256 ? cb : cb - 256;
    const int nsmp = (4096 - (cb % 256) + G - 1) / G;
    const int nunits = np + nsmp;
    f32x4 S[2][4]; f32x4 O[2];
    u32x4 qpre[4], kpre[4]; bf16_t vpre[8];
    const int vv = tid & 63, jg = tid >> 6;
#define RT_DECODE(u, b_, h_, vs_, ck_, smp_, row0_, len_) do { if ((u) < np) { b_ = cb >> 5; h_ = (cb >> 3) & 3; vs_ = cb & 7; ck_ = (u); smp_ = false; row0_ = b_ * TP + 64 * ck_; len_ = ck_ < 32 ? 64 : 16; } \
        else { const int it_ = (cb % 256) + ((u) - np) * G; b_ = it_ >> 5; h_ = (it_ >> 3) & 3; vs_ = it_ & 7; ck_ = 0; smp_ = true; row0_ = RP + 8 * b_; len_ = 8; } } while (0)
#define RT_LOAD(u) do { int b_, h_, vs_, ck_, row0_, len_; bool smp_; RT_DECODE(u, b_, h_, vs_, ck_, smp_, row0_, len_); \
        _Pragma("unroll") for (int e = 0; e < 4; ++e) { const int idx = tid + 512 * e, i = idx >> 5, cc = idx & 31; const size_t o = (size_t)(row0_ + i) * 1024 + h_ * 256 + 8 * cc; \
            const u32x4 q_ = *(const u32x4*)(Qg + o), k_ = *(const u32x4*)(Kg + o); const bool valid = i < len_; const u32x4 zz = {0u, 0u, 0u, 0u}; qpre[e] = valid ? q_ : zz; kpre[e] = valid ? k_ : zz; } \
        _Pragma("unroll") for (int e = 0; e < 8; ++e) { const int j = 8 * jg + e; const bf16_t v_ = Vg[(size_t)(row0_ + j) * 2048 + h_ * 512 + vs_ * 64 + vv]; vpre[e] = (j < len_) ? v_ : (bf16_t)0; } } while (0)
    (void)s0;
    if (nunits > 0) RT_LOAD(0);
    const int ntot_ = np + nsmp * REP_SMP;
    for (int uu = 0; uu < ntot_; ++uu) { const int u = uu < np ? uu : np + (uu - np) % nsmp; const int un_ = uu + 1 < np ? uu + 1 : np + (uu + 1 - np) % nsmp;
        int b, h, vs, ck, row0, len; bool sample; RT_DECODE(u, b, h, vs, ck, sample, row0, len);
        const bool first = sample || ck == 0, last = sample || ck == 32;
        const float lgam = __logf(1.f - exp2f(-5.f - (float)h));
        if (first) state_load<256, 64>(S, AIN(3) + (((size_t)b * 4 + h) * 256) * 512 + vs * 64, 512, wid, fr, fq, !sample);
#pragma unroll
        for (int e = 0; e < 4; ++e) { const int idx = tid + 512 * e, i = idx >> 5, cc = idx & 31; *(u32x4*)(QA + i * LQ + 8 * cc) = qpre[e]; *(u32x4*)(KB + i * LQ + 8 * cc) = kpre[e]; }
        *(u32x4*)(VT + vv * LJ + 8 * jg) = (u32x4){(unsigned)vpre[0] | ((unsigned)vpre[1] << 16), (unsigned)vpre[2] | ((unsigned)vpre[3] << 16), (unsigned)vpre[4] | ((unsigned)vpre[5] << 16), (unsigned)vpre[6] | ((unsigned)vpre[7] << 16)};
        if (tid < 64) { GI[tid] = (float)((tid + 1 < len) ? tid + 1 : len) * lgam; DECJ[tid] = tid < len ? __expf((float)(len - 1 - tid) * lgam) : 0.f; }
        if (tid < 256) SDEC[tid] = __expf((float)len * lgam);
        __syncthreads();
        if (uu + 1 < ntot_) RT_LOAD(un_);
        { const int cp = tid & 127, jq = tid >> 7;
          float dj[16];
#pragma unroll
          for (int q4 = 0; q4 < 4; ++q4) { const f32x4 t = *(const f32x4*)(DECJ + 16 * jq + 4 * q4); dj[4 * q4] = t[0]; dj[4 * q4 + 1] = t[1]; dj[4 * q4 + 2] = t[2]; dj[4 * q4 + 3] = t[3]; }
          unsigned lo[8], hi[8];
#pragma unroll
          for (int e = 0; e < 8; ++e) { const int j = 16 * jq + 2 * e; const unsigned w0 = *(const unsigned*)(KB + j * LQ + 2 * cp), w1 = *(const unsigned*)(KB + (j + 1) * LQ + 2 * cp);
              lo[e] = cvt_pk_bf16(__uint_as_float(w0 << 16) * dj[2 * e], __uint_as_float(w1 << 16) * dj[2 * e + 1]);
              hi[e] = cvt_pk_bf16(__uint_as_float(w0 & 0xffff0000u) * dj[2 * e], __uint_as_float(w1 & 0xffff0000u) * dj[2 * e + 1]); }
          *(u32x4*)(KT + (2 * cp) * LJ + 16 * jq) = (u32x4){lo[0], lo[1], lo[2], lo[3]}; *(u32x4*)(KT + (2 * cp) * LJ + 16 * jq + 8) = (u32x4){lo[4], lo[5], lo[6], lo[7]};
          *(u32x4*)(KT + (2 * cp + 1) * LJ + 16 * jq) = (u32x4){hi[0], hi[1], hi[2], hi[3]}; *(u32x4*)(KT + (2 * cp + 1) * LJ + 16 * jq + 8) = (u32x4){hi[4], hi[5], hi[6], hi[7]}; }
        scan_core<256, 64, false>(QA, KB, QA, KT, VT, VT, ST, P, GI, SDEC, S, O, wid, fr, fq);
        const int m = wid >> 1, hw = wid & 1, i = 16 * m + fr;
        if (i < len) {
#pragma unroll
            for (int vt = 0; vt < 2; ++vt) *(u32x2*)(OB + (size_t)(row0 + i) * 2048 + h * 512 + vs * 64 + 16 * (hw * 2 + vt) + 4 * fq) = (u32x2){cvt_pk_bf16(O[vt][0], O[vt][1]), cvt_pk_bf16(O[vt][2], O[vt][3])}; }
        if (last) { float* dst = a->out + (sample ? O_RTS : O_RTP) + (((size_t)b * 4 + h) * 256) * 512 + vs * 64; state_store<256, 64>(S, dst, 512, wid, fr, fq); }
        __syncthreads();
    }
#undef RT_DECODE
#undef RT_LOAD
}

__device__ __forceinline__ void mamba_block(ArgsP a_, unsigned char* smem) { const ArgsP a = a_;
    constexpr int LQ = 136, LJ = 72;
    bf16_t* QA = (bf16_t*)smem; bf16_t* KB = (bf16_t*)(smem + 17408); bf16_t* KT = (bf16_t*)(smem + 34816); bf16_t* VT = (bf16_t*)(smem + 53248); bf16_t* VT2 = (bf16_t*)(smem + 62464);
    bf16_t* ST = (bf16_t*)(smem + 71680); bf16_t* P = (bf16_t*)(smem + 89088); float* GI = (float*)(smem + 98304); float* SDEC = (float*)(smem + 98560); float* DTV = (float*)(smem + 99072); float* W2 = (float*)(smem + 99584);
    const int tid = TID(), wid = tid >> 6, lane = tid & 63, fr = lane & 15, fq = lane >> 4;
    const int G = gridDim.x, cb0 = BID();
    const int cb = (G == 256) ? ((((cb0 & 7) * 8 + (cb0 >> 5)) << 2) | ((cb0 >> 3) & 3)) : cb0;
    const unsigned char* proj = a->ws + B_PROJ;
    const bf16_t* ZG = (const bf16_t*)proj; const float* DT = (const float*)(proj + (size_t)MP * 12288); const bf16_t* XC = (const bf16_t*)(proj + (size_t)MP * 13312);
    bf16_t* YB = (bf16_t*)(a->ws + B_PART);
    const int np = cb < 256 ? 33 : 0; const int nsmp = (4096 - (cb % 256) + G - 1) / G; const int nunits = np + nsmp;
    f32x4 S[1][4]; f32x4 O[2];
    u32x4 bpre[2], cpre[2]; bf16_t xpre[8]; float dtpre = 0.f;
    const int vv = tid & 63, jg = tid >> 6;
#define MB_DECODE(u, b_, hd_, ck_, smp_, row0_, len_) do { if ((u) < np) { b_ = cb >> 5; hd_ = cb & 31; ck_ = (u); smp_ = false; row0_ = b_ * TP + 64 * ck_; len_ = ck_ < 32 ? 64 : 16; } \
        else { const int it_ = (cb % 256) + ((u) - np) * G; b_ = it_ >> 5; hd_ = it_ & 31; ck_ = 0; smp_ = true; row0_ = RP + 8 * b_; len_ = 8; } } while (0)
#define MB_LOAD(u) do { int b_, hd_, ck_, row0_, len_; bool smp_; MB_DECODE(u, b_, hd_, ck_, smp_, row0_, len_); const int grp_ = hd_ >> 2; \
        _Pragma("unroll") for (int e = 0; e < 2; ++e) { const int idx = tid + 512 * e, i = idx >> 4, cc = idx & 15; const size_t o = (size_t)(row0_ + i) * 4096 + 2048 + 128 * grp_ + 8 * cc; \
            const u32x4 b4 = *(const u32x4*)(XC + o), c4 = *(const u32x4*)(XC + o + 1024); const bool valid = i < len_; const u32x4 zz = {0u, 0u, 0u, 0u}; bpre[e] = valid ? b4 : zz; cpre[e] = valid ? c4 : zz; } \
        _Pragma("unroll") for (int e = 0; e < 8; ++e) { const int j = 8 * jg + e; const bf16_t x_ = XC[(size_t)(row0_ + j) * 4096 + hd_ * 64 + vv]; xpre[e] = (j < len_) ? x_ : (bf16_t)0; } \
        if (tid < 64) dtpre = DT[(size_t)(row0_ + tid) * 256 + hd_]; } while (0)
    if (nunits > 0) MB_LOAD(0);
    const int ntot_ = np + nsmp * REP_SMP;
    for (int uu = 0; uu < ntot_; ++uu) { const int u = uu < np ? uu : np + (uu - np) % nsmp; const int un_ = uu + 1 < np ? uu + 1 : np + (uu + 1 - np) % nsmp;
        int b, hd, ck, row0, len; bool sample; MB_DECODE(u, b, hd, ck, sample, row0, len);
        const bool first = sample || ck == 0, last = sample || ck == 32;
        if (first) state_load<128, 64>(S, AIN(4) + (((size_t)b * 32 + hd) * 128) * 64, 64, wid, fr, fq, !sample);
#pragma unroll
        for (int e = 0; e < 2; ++e) { const int idx = tid + 512 * e, i = idx >> 4, cc = idx & 15; *(u32x4*)(KB + i * LQ + 8 * cc) = bpre[e]; *(u32x4*)(QA + i * LQ + 8 * cc) = cpre[e]; }
        if (tid < 64) { const int j = tid; const bool valid = j < len; const float dtr = dtpre + AIN(22)[hd];
            const float dt = valid ? (dtr > 20.f ? dtr : log1pf(__expf(dtr))) : 0.f; float x = -dt * __expf(AIN(23)[hd]);
#pragma unroll
            for (int off = 1; off < 64; off <<= 1) { const float t = __shfl_up(x, off); if (lane >= off) x += t; }
            const float glast = __shfl(x, 63); GI[j] = x; DTV[j] = dt; W2[j] = dt * __expf(glast - x); const float ed = __expf(glast); SDEC[2 * j] = ed; SDEC[2 * j + 1] = ed; }
        __syncthreads();
        { unsigned w1[4], w2[4];
#pragma unroll
          for (int e = 0; e < 4; ++e) { const int j = 8 * jg + 2 * e; const float x0 = bf2f(xpre[2 * e]), x1 = bf2f(xpre[2 * e + 1]);
              w1[e] = cvt_pk_bf16(x0 * DTV[j], x1 * DTV[j + 1]); w2[e] = cvt_pk_bf16(x0 * W2[j], x1 * W2[j + 1]); }
          *(u32x4*)(VT + vv * LJ + 8 * jg) = (u32x4){w1[0], w1[1], w1[2], w1[3]}; *(u32x4*)(VT2 + vv * LJ + 8 * jg) = (u32x4){w2[0], w2[1], w2[2], w2[3]}; }
        { const int cp = tid & 63, jq = tid >> 6;
          unsigned lo[4], hi[4];
#pragma unroll
          for (int e = 0; e < 4; ++e) { const int j = 8 * jq + 2 * e; const unsigned w0 = *(const unsigned*)(KB + j * LQ + 2 * cp), w1 = *(const unsigned*)(KB + (j + 1) * LQ + 2 * cp);
              lo[e] = (w0 & 0xffffu) | (w1 << 16); hi[e] = (w0 >> 16) | (w1 & 0xffff0000u); }
          *(u32x4*)(KT + (2 * cp) * LJ + 8 * jq) = (u32x4){lo[0], lo[1], lo[2], lo[3]}; *(u32x4*)(KT + (2 * cp + 1) * LJ + 8 * jq) = (u32x4){hi[0], hi[1], hi[2], hi[3]}; }
        if (uu + 1 < ntot_) MB_LOAD(un_);
        scan_core<128, 64, false>(QA, KB, QA, KT, VT, VT2, ST, P, GI, SDEC, S, O, wid, fr, fq);
        const int m = wid >> 1, hw = wid & 1, i = 16 * m + fr;
        if (i < len) { const float Dh = AIN(24)[hd];
#pragma unroll
            for (int vt = 0; vt < 2; ++vt) { const int v = 16 * (hw * 2 + vt) + 4 * fq; const size_t o = (size_t)(row0 + i) * 2048 + hd * 64 + v;
                const u32x2 xt = *(const u32x2*)(XC + (size_t)(row0 + i) * 4096 + hd * 64 + v); const u32x2 zt = *(const u32x2*)(ZG + o);
                const f32x4 xs = {__uint_as_float(xt.x << 16), __uint_as_float(xt.x & 0xffff0000u), __uint_as_float(xt.y << 16), __uint_as_float(xt.y & 0xffff0000u)};
                const f32x4 zg = {__uint_as_float(zt.x << 16), __uint_as_float(zt.x & 0xffff0000u), __uint_as_float(zt.y << 16), __uint_as_float(zt.y & 0xffff0000u)};
                const f32x4 y = (O[vt] + xs * Dh) * zg; *(u32x2*)(YB + o) = (u32x2){cvt_pk_bf16(y[0], y[1]), cvt_pk_bf16(y[2], y[3])}; } }
        if (last) { float* dst = a->out + (sample ? O_SSS : O_SSP) + (((size_t)b * 32 + hd) * 128) * 64; state_store<128, 64>(S, dst, 64, wid, fr, fq); }
        __syncthreads();
    }
#undef MB_DECODE
#undef MB_LOAD
}

__device__ __forceinline__ void scan_phase(ArgsP a_, int kind, int jl, unsigned char* smem) { const ArgsP a = a_;
    if (kind == 0) { hg_block(a, jl, smem);
    }
    else if (kind == 1) ret_block(a, smem); else mamba_block(a, smem);
}

__device__ __forceinline__ void conv_phase(ArgsP a_) { const ArgsP a = a_;
    const unsigned char* proj = a->ws + B_PROJ; const bf16_t* XBC = (const bf16_t*)(proj + (size_t)MP * 4096); bf16_t* XC = (bf16_t*)(proj + (size_t)MP * 13312);
    const float* cw = AIN(20); const float* cbias = AIN(21); const float* c0 = AIN(5);
    const size_t gt = (size_t)BID() * 512 + TID(), gs = (size_t)gridDim.x * 512;
    for (size_t t = gt; t < (size_t)(8 * 129 + 128) * 512; t += gs) {
        const int cg8 = (int)(t & 511), seg = (int)(t >> 9); const int col = cg8 * 8;
        int row0, nrow, hist; const float* st = nullptr;
        if (seg < 8 * 129) { const int b = seg / 129, s = seg % 129; row0 = b * TP + 16 * s; nrow = 16; hist = s == 0 ? 0 : 1; }
        else { const int b = seg - 8 * 129; row0 = RP + 8 * b; nrow = 8; hist = 2; st = c0 + (size_t)b * 3 * 4096 + col; }
        float w[4][8], bs[8];
#pragma unroll
        for (int k = 0; k < 4; ++k) { const f32x4 x0 = *(const f32x4*)(cw + k * 4096 + col), x1 = *(const f32x4*)(cw + k * 4096 + col + 4);
#pragma unroll
            for (int e = 0; e < 4; ++e) { w[k][e] = x0[e]; w[k][4 + e] = x1[e]; } }
        { const f32x4 x0 = *(const f32x4*)(cbias + col), x1 = *(const f32x4*)(cbias + col + 4);
#pragma unroll
          for (int e = 0; e < 4; ++e) { bs[e] = x0[e]; bs[4 + e] = x1[e]; } }
        float r[3][8];
#pragma unroll
        for (int k = 0; k < 3; ++k) {
            if (hist == 0) {
#pragma unroll
                for (int e = 0; e < 8; ++e) r[k][e] = 0.f;
            } else if (hist == 1) { const u32x4 x = *(const u32x4*)(XBC + (size_t)(row0 - 3 + k) * 4096 + col);
                r[k][0] = __uint_as_float(x.x << 16); r[k][1] = __uint_as_float(x.x & 0xffff0000u); r[k][2] = __uint_as_float(x.y << 16); r[k][3] = __uint_as_float(x.y & 0xffff0000u);
                r[k][4] = __uint_as_float(x.z << 16); r[k][5] = __uint_as_float(x.z & 0xffff0000u); r[k][6] = __uint_as_float(x.w << 16); r[k][7] = __uint_as_float(x.w & 0xffff0000u);
            } else { const f32x4 x0 = *(const f32x4*)(st + k * 4096), x1 = *(const f32x4*)(st + k * 4096 + 4);
#pragma unroll
                for (int e = 0; e < 4; ++e) { r[k][e] = x0[e]; r[k][4 + e] = x1[e]; } }
        }
        for (int j = 0; j < nrow; ++j) {
            const u32x4 x = *(const u32x4*)(XBC + (size_t)(row0 + j) * 4096 + col); float cur[8];
            cur[0] = __uint_as_float(x.x << 16); cur[1] = __uint_as_float(x.x & 0xffff0000u); cur[2] = __uint_as_float(x.y << 16); cur[3] = __uint_as_float(x.y & 0xffff0000u);
            cur[4] = __uint_as_float(x.z << 16); cur[5] = __uint_as_float(x.z & 0xffff0000u); cur[6] = __uint_as_float(x.w << 16); cur[7] = __uint_as_float(x.w & 0xffff0000u);
            float y[8];
#pragma unroll
            for (int e = 0; e < 8; ++e) { y[e] = siluf(bs[e] + w[0][e] * r[0][e] + w[1][e] * r[1][e] + w[2][e] * r[2][e] + w[3][e] * cur[e]); r[0][e] = r[1][e]; r[1][e] = r[2][e]; r[2][e] = cur[e]; }
            *(u32x4*)(XC + (size_t)(row0 + j) * 4096 + col) = (u32x4){cvt_pk_bf16(y[0], y[1]), cvt_pk_bf16(y[2], y[3]), cvt_pk_bf16(y[4], y[5]), cvt_pk_bf16(y[6], y[7])};
        }
    }
}

__device__ __forceinline__ void norm_phase(ArgsP a_, int kind) { const ArgsP a = a_;
    const int lane = TID() & 63, wv = TID() >> 6; const int gw = BID() * 8 + wv, nw = gridDim.x * 8;
    const bf16_t* OB = (const bf16_t*)(a->ws + B_PART); bf16_t* ON = (bf16_t*)(a->ws + B_ACT); const unsigned char* proj = a->ws + B_PROJ;
    const float* ngp = (kind == 1 ? AIN(17) : AIN(25)) + lane * 32;
    f32x4 gq[8];
#pragma unroll
    for (int q = 0; q < 8; ++q) gq[q] = *(const f32x4*)(ngp + 4 * q);
    const bf16_t* Gg = (const bf16_t*)(proj + (size_t)MP * 8192);
    const bool xa = gridDim.x == 256; const int xb0 = (BID() & 7) * (M_ / 8);
    const int row_lo = xa ? xb0 + (BID() >> 3) * 8 + wv : gw, row_hi = xa ? xb0 + M_ / 8 : M_, row_st = xa ? 256 : nw;
    for (int row = row_lo; row < row_hi; row += row_st) {
        const size_t o = (size_t)row * 2048 + lane * 32;
        u32x4 xr[4], gr[4];
#pragma unroll
        for (int q = 0; q < 4; ++q) xr[q] = *(const u32x4*)(OB + o + 8 * q);
        if (kind == 1) {
#pragma unroll
            for (int q = 0; q < 4; ++q) gr[q] = *(const u32x4*)(Gg + o + 8 * q);
        }
        float x[32];
#pragma unroll
        for (int q = 0; q < 4; ++q)
#pragma unroll
            for (int e = 0; e < 4; ++e) { x[8 * q + 2 * e] = __uint_as_float(xr[q][e] << 16); x[8 * q + 2 * e + 1] = __uint_as_float(xr[q][e] & 0xffff0000u); }
        float mean = 0.f, rstd;
        if (kind == 1) {
            float s1 = 0.f;
#pragma unroll
            for (int e = 0; e < 32; ++e) s1 += x[e];
            s1 += __shfl_xor(s1, 1); s1 += __shfl_xor(s1, 2); s1 += __shfl_xor(s1, 4); s1 += __shfl_xor(s1, 8);
            mean = s1 * (1.f / 512.f);
            float s2 = 0.f;
#pragma unroll
            for (int e = 0; e < 32; ++e) { const float d = x[e] - mean; s2 += d * d; }
            s2 += __shfl_xor(s2, 1); s2 += __shfl_xor(s2, 2); s2 += __shfl_xor(s2, 4); s2 += __shfl_xor(s2, 8);
            rstd = rsqrtf(s2 * (1.f / 512.f) + LN_EPS);
        } else {
            float s2 = 0.f;
#pragma unroll
            for (int e = 0; e < 32; ++e) s2 += x[e] * x[e];
            s2 += __shfl_xor(s2, 1); s2 += __shfl_xor(s2, 2); s2 += __shfl_xor(s2, 4);
            rstd = rsqrtf(s2 * (1.f / 256.f) + LN_EPS);
        }
#pragma unroll
        for (int q = 0; q < 4; ++q) {
            float y[8];
#pragma unroll
            for (int e = 0; e < 8; ++e) y[e] = (x[8 * q + e] - mean) * rstd * gq[2 * q + (e >> 2)][e & 3];
            if (kind == 1) {
#pragma unroll
                for (int e = 0; e < 4; ++e) { y[2 * e] *= __uint_as_float(gr[q][e] << 16); y[2 * e + 1] *= __uint_as_float(gr[q][e] & 0xffff0000u); }
            }
            *(u32x4*)(ON + o + 8 * q) = (u32x4){cvt_pk_bf16(y[0], y[1]), cvt_pk_bf16(y[2], y[3]), cvt_pk_bf16(y[4], y[5]), cvt_pk_bf16(y[6], y[7])};
        }
    }
    if (kind != 1) {
        const bf16_t* XBC = (const bf16_t*)(proj + (size_t)MP * 4096);
        const size_t gt = (size_t)BID() * 512 + TID(), gs = (size_t)gridDim.x * 512;
        for (size_t i = gt; i < (size_t)(8 + 128) * 3 * 4096; i += gs) { const int col = (int)(i & 4095); const int rk = (int)(i >> 12); const int bb = rk / 3, k = rk % 3;
            if (bb < 8) a->out[O_CVP + i] = bf2f(XBC[(size_t)(bb * TP + TP - 3 + k) * 4096 + col]);
            else { const int sb = bb - 8; a->out[O_CVS + ((size_t)sb * 3 + k) * 4096 + col] = bf2f(XBC[(size_t)(RP + sb * 8 + 5 + k) * 4096 + col]); } }
    }
}

__device__ __forceinline__ void decode_phase(int p, int& L, int& sub) {
    if (p == 0) { L = -1; sub = -1; return; }
    p -= 1;
    for (int l = 0; l < 4; ++l) { const int kind = l % 3; const int n = kind == 0 ? 10 : (kind == 1 ? 11 : 12);
        if (p < n) { L = l;
            if (kind == 0) sub = p < 5 ? p : p + 1;
            else if (kind == 1) sub = p;
            else sub = p < 4 ? p : (p == 4 ? 11 : p - 1);
            return; }
        p -= n; }
    L = -2; sub = -2;
}
constexpr int NPHASE = 1 + 10 + 11 + 12 + 10;
#ifndef REP_SETUP
#define REP_SETUP 1
#endif
#ifndef REP_SCAN
#define REP_SCAN 1
#endif

__global__ void __launch_bounds__(512, 2) fwd_megakernel(Args a_unused) {
    extern __shared__ __attribute__((aligned(16))) unsigned char smem[];
    cg::grid_group grid = cg::this_grid();
    const ArgsP ka = (ArgsP)__builtin_amdgcn_kernarg_segment_ptr();
    const int ph_lo = ka->ph_lo, ph_hi = ka->ph_hi;
    volatile LAS unsigned* xst = (volatile LAS unsigned*)(smem + LDS_BYTES - 16);
    if (threadIdx.x == 0) { xst[0] = 0u; xst[1] = 0u; }
    __syncthreads();
    const XcdBarrier xb = xcd_barrier_post((unsigned*)(ka->ws + B_BAR), xst);
    for (int p = ph_lo; p < ph_hi; ++p) {
        int L, sub; decode_phase(p, L, sub);
        const ArgsP a = launder(ka);
        const int G = gridDim.x, c = BID();
        if (L == -1) { for (int rep = 0; rep < REP_SETUP; ++rep) { setup_phase(launder(ka), smem); __syncthreads(); } }
        else if (L >= 0) {
            const int kind = L % 3, jl = L / 3;
            unsigned char* ws = a->ws;
            pg8::Gemm g; pg8::SplitOrder S;
            switch (sub) {
            case 0: case 8: { const int f = sub == 0 ? 0 : 1; g.A = (const bf16_t*)(ws + B_HB8); g.lda = 512; g.Bt = (const bf16_t*)(ws + W_GU + (size_t)(2 * L + f) * 5632 * 1024); g.ldb = 512; g.K = 512;
                S.init(69, 22, 1, G, c); EpiSwiglu E{ws + B_ACT}; for (int rep = 0; rep < REP_GEMM; ++rep) { pg8::gemm_phase<EpiSwiglu, true>((LAS unsigned char*)smem, g, S, E); } } break;
            case 1: case 9: { const int f = sub == 1 ? 0 : 1; g.A = (const bf16_t*)(ws + B_ACT); g.lda = DFF / 2; g.ldb = DFF / 2; g.K = DFF / 2; g.Bt = (const bf16_t*)(ws + W_D + (size_t)(2 * L + f) * 1024 * DFF);
                S.init_sk(69, 4, 11, G, c); EpiPart E{(bf16_t*)(ws + B_PARTB), 1.f / (SC_ACT * SC_WD)}; for (int rep = 0; rep < REP_GEMM; ++rep) { pg8::gemm_phase<EpiPart, true>((LAS unsigned char*)smem, g, S, E); } } break;
            case 6: { g.A = (const bf16_t*)(ws + B_ACT);
                if (kind == 0) { g.lda = 1024; g.ldb = 1024; g.K = 512; g.Bt = (const bf16_t*)(ws + W_HGO) + (size_t)jl * 1024 * 1024; }
                else { g.lda = 2048; g.ldb = 2048; g.K = 1024; g.Bt = (const bf16_t*)(ws + (kind == 1 ? W_RO : W_MO)); }
                S.init_sk(69, 4, (kind == 0 ? 8 : 16), G, c); EpiPart E{(bf16_t*)(ws + B_PARTB), 1.f}; for (int rep = 0; rep < REP_GEMM; ++rep) { pg8::gemm_phase<EpiPart, false>((LAS unsigned char*)smem, g, S, E); } } break;
            case 2: ln_phase(a, L * 3 + 0, 0.5f, false); break;
            case 7: ln_phase(a, L * 3 + 1, 1.0f, false); break;
            case 10: ln_phase(a, L * 3 + 2, 0.5f, L == 3); break;
            case 3: { g.A = (const bf16_t*)(ws + B_HB); g.lda = 1024; g.ldb = 1024; g.K = 1024;
                const float* rc = (const float*)(ws + B_ROPE);
                if (kind == 0) { g.Bt = (const bf16_t*)(ws + W_HGI) + (size_t)jl * 4096 * 1024; S.init(69, 16, 1, G, c); EpiProj<0> E{ws + B_PROJ, rc, rc + NPOS * 128, (const float*)(ws + B_LB) + jl * 1024}; for (int rep = 0; rep < REP_GEMM; ++rep) { pg8::gemm_phase<decltype(E), false>((LAS unsigned char*)smem, g, S, E); } }
                else if (kind == 1) { g.Bt = (const bf16_t*)(ws + W_RI); S.init(69, 24, 1, G, c); EpiProj<1> E{ws + B_PROJ, rc, rc + NPOS * 128, nullptr}; for (int rep = 0; rep < REP_GEMM; ++rep) { pg8::gemm_phase<decltype(E), false>((LAS unsigned char*)smem, g, S, E); } }
                else { g.Bt = (const bf16_t*)(ws + W_MI); S.init(69, 25, 1, G, c); EpiProj<2> E{ws + B_PROJ, rc, rc + NPOS * 128, nullptr}; for (int rep = 0; rep < REP_GEMM; ++rep) { pg8::gemm_phase<decltype(E), false>((LAS unsigned char*)smem, g, S, E); } } } break;
#ifndef NO_SCAN
            case 4: for (int rep = 0; rep < REP_SCAN; ++rep) { scan_phase(launder(ka), kind, jl, smem); __syncthreads(); } break;
#endif
            case 5: norm_phase(a, kind); break;
            case 11: conv_phase(a); break;
            default: break;
            }
        }
        if (p + 1 < ph_hi) { if (p == ph_lo) grid.sync(); else xcd_barrier(xb); }
    }
}

extern "C" void kernel_launch(void* const* d_in, const int* in_sizes, int n_in, void* d_out, int out_size, void* d_ws, size_t ws_size, hipStream_t stream) {
    static int grid_blocks = 0;
    if (!grid_blocks) {
        int dev = 0, cus = 0, per_cu = 0;
        (void)hipGetDevice(&dev);
        (void)hipDeviceGetAttribute(&cus, hipDeviceAttributeMultiprocessorCount, dev);
        if (hipFuncSetAttribute((const void*)fwd_megakernel, hipFuncAttributeMaxDynamicSharedMemorySize, LDS_BYTES) != hipSuccess) fprintf(stderr, "hipFuncSetAttribute failed\n");
        if (hipOccupancyMaxActiveBlocksPerMultiprocessor(&per_cu, (const void*)fwd_megakernel, 512, LDS_BYTES) != hipSuccess || per_cu < 1) { fprintf(stderr, "occupancy query says %d\n", per_cu); per_cu = 1; }
        (void)hipGetLastError();
        grid_blocks = cus * 1;
        if (ws_size < WS_END) fprintf(stderr, "workspace too small: %zu < %zu\n", ws_size, (size_t)WS_END);
    }
    Args a{};
    for (int i = 0; i < 27; ++i) a.in[i] = (const float*)d_in[i];
    a.out = (float*)d_out; a.ws = (unsigned char*)d_ws; a.ph_lo = 0; a.ph_hi = NPHASE;
    (void)hipMemsetAsync((unsigned char*)d_ws + B_BAR, 0, 3456 * 4, stream);
    void* args[] = {&a};
    hipError_t e = hipLaunchCooperativeKernel((const void*)fwd_megakernel, dim3(grid_blocks), dim3(512), args, LDS_BYTES, stream);
    if (e != hipSuccess) fprintf(stderr, "cooperative launch failed: %s (grid %d)\n", hipGetErrorString(e), grid_blocks);
}
```

```cpp
#include <hip/hip_runtime.h>
#include <hip/hip_cooperative_groups.h>
#include <cstdio>
namespace cg = cooperative_groups;

#define LAS __attribute__((address_space(3)))
typedef unsigned short bf16_t;
typedef short bf16x8 __attribute__((ext_vector_type(8)));
typedef float f32x4 __attribute__((ext_vector_type(4)));
typedef unsigned u32x4 __attribute__((ext_vector_type(4)));
typedef unsigned u32x2 __attribute__((ext_vector_type(2)));

constexpr int D = 1024, TP = 2064, RP = 8 * TP  , RS_ = 1024, M_ = RP + RS_  , MP = 17664, DFF = 2816;
constexpr int NPOS = TP + 8;
constexpr float ALPHA = 1.681792830507429f, LN_EPS = 1e-5f;
constexpr int LDS_BYTES = 163840;

constexpr size_t O_YP = 0, O_YS = O_YP + 8ull * 2048 * 1024, O_HGP = O_YS + 128ull * 8 * 1024, O_HGS = O_HGP + 2ull * 8 * 8 * 128 * 128,
                 O_RTP = O_HGS + 2ull * 128 * 8 * 128 * 128, O_RTS = O_RTP + 8ull * 4 * 256 * 512, O_SSP = O_RTS + 128ull * 4 * 256 * 512,
                 O_SSS = O_SSP + 8ull * 32 * 128 * 64, O_CVP = O_SSS + 128ull * 32 * 128 * 64, O_CVS = O_CVP + 8ull * 3 * 4096;

constexpr size_t al256(size_t x) { return (x + 255) & ~(size_t)255; }
constexpr size_t W_GU = 0;
constexpr size_t W_D = W_GU + 8ull * 5632 * 1024 * 2;
constexpr size_t W_HGI = W_D + 8ull * 1024 * 2816 * 2;
constexpr size_t W_HGO = W_HGI + 2ull * 4096 * 1024 * 2;
constexpr size_t W_RI = W_HGO + 2ull * 1024 * 1024 * 2;
constexpr size_t W_RO = W_RI + 6144ull * 1024 * 2;
constexpr size_t W_MI = W_RO + 1024ull * 2048 * 2;
constexpr size_t W_MO = W_MI + 6400ull * 1024 * 2;
constexpr size_t B_HF = W_MO + 1024ull * 2048 * 2;
constexpr size_t B_PARTB = B_HF;
constexpr size_t B_HB = B_HF + (size_t)MP * 1024 * 4;
constexpr size_t B_ACT = B_HB + (size_t)MP * 1024 * 2;
constexpr size_t B_PART = B_ACT + (size_t)MP * 2816 * 2;
constexpr size_t B_PROJ = B_PART + 2ull * MP * 1024 * 4;
constexpr size_t B_ROPE = B_PROJ + (size_t)MP * 21504;
constexpr size_t B_LB = B_ROPE + 2ull * NPOS * 128 * 4;
constexpr size_t B_BAR = B_LB + 2 * 1024 * 4;
constexpr size_t B_HB8 = B_BAR + 3456 * 4 + 256;
constexpr size_t WS_END = B_HB8 + (size_t)MP * 1024;

struct Args {
    const float* in[27];
    float* out;
    unsigned char* ws;
    int ph_lo, ph_hi;
};

#ifndef REP_SMP
#define REP_SMP 1
#endif
#ifndef REP_GEMM
#define REP_GEMM 1
#endif
typedef const Args __attribute__((address_space(4)))* ArgsP;
__device__ __forceinline__ ArgsP launder(ArgsP p) { asm volatile("" : "+s"(p)); return p; }
#define AIN(k) ((const float*)a->in[k])
__device__ __forceinline__ int TID() { int t = threadIdx.x; asm volatile("" : "+v"(t)); return t; }
__device__ __forceinline__ int BID() { int t = blockIdx.x; asm volatile("" : "+s"(t)); return t; }
__device__ __forceinline__ unsigned cvt_pk_bf16(float lo, float hi) { unsigned r; asm("v_cvt_pk_bf16_f32 %0, %1, %2" : "=v"(r) : "v"(lo), "v"(hi)); return r; }
__device__ __forceinline__ bf16_t f2bf(float f) { return (bf16_t)(cvt_pk_bf16(f, 0.f) & 0xffffu); }
__device__ __forceinline__ float bf2f(bf16_t b) { return __uint_as_float(((unsigned)b) << 16); }
__device__ __forceinline__ float siluf(float x) { return x * __builtin_amdgcn_rcpf(1.0f + __expf(-x)); }
typedef int i32x4 __attribute__((ext_vector_type(4)));
typedef int i32x8 __attribute__((ext_vector_type(8)));
__device__ __forceinline__ float clamp448(float x) { return fminf(fmaxf(x, -448.f), 448.f); }
__device__ __forceinline__ unsigned pk_fp8x4(float a, float b, float c, float d) { int w = 0; w = __builtin_amdgcn_cvt_pk_fp8_f32(clamp448(a), clamp448(b), w, false); w = __builtin_amdgcn_cvt_pk_fp8_f32(clamp448(c), clamp448(d), w, true); return (unsigned)w; }
constexpr float SC_H = 11.3f, SC_WGU = 181.f, SC_ACT = 5.66f, SC_WD = 724.f;
__device__ __forceinline__ float wave_sum(float v) {
#pragma unroll
    for (int o = 32; o >= 1; o >>= 1) v += __shfl_xor(v, o);
    return v;
}
__device__ __forceinline__ int pos_index(int row) { return row < RP ? row % TP : (row < M_ ? TP + ((row - RP) & 7) : 0); }


#define XB_TMO      128
#define XB_XCNT(j)  (256  + 64 * (j))
#define XB_XSUB(j)  (1280 + 64 * (j))
#define XB_XGEN(j)  (2304 + 64 * (j))
#define XB_TOP      3328
#define XB_TOPGEN   3392
#define XCD_BAR_WORDS 3456
#define XB_SPIN_CAP (1u << 18)
__device__ __forceinline__ unsigned xb_ld(unsigned* p)              { return __hip_atomic_load(p, __ATOMIC_RELAXED, __HIP_MEMORY_SCOPE_AGENT); }
__device__ __forceinline__ unsigned xb_add(unsigned* p, unsigned v) { return __hip_atomic_fetch_add(p, v, __ATOMIC_RELAXED, __HIP_MEMORY_SCOPE_AGENT); }
__device__ __forceinline__ unsigned xb_xcc_id() { return (unsigned)__builtin_amdgcn_s_getreg((3 << 11) | 20) & 0xFu; }
#define XB_SPIN(cond, bar) do { unsigned _sp = 0; while (cond) { __builtin_amdgcn_s_sleep(1); \
    if ((++_sp & 255u) == 0u) { if (xb_ld(&(bar)[XB_TMO])) break; if (_sp > XB_SPIN_CAP) { atomicAdd(&(bar)[XB_TMO], 1u); break; } } } } while (0)
struct XcdBarrier { unsigned* bar; unsigned x; volatile LAS unsigned* st; };
__device__ __forceinline__ XcdBarrier xcd_barrier_post(unsigned* bar, volatile LAS unsigned* st) {
    XcdBarrier b; b.bar = bar; b.x = xb_xcc_id(); b.st = st;
    if (threadIdx.x == 0) (void)xb_add(&bar[XB_XCNT(b.x)], 1u);
    return b;
}
__device__ __forceinline__ void xcd_barrier_complete(unsigned* bar, unsigned x, unsigned& nloc, unsigned& nx) {
    const unsigned G = gridDim.x * gridDim.y * gridDim.z;
    unsigned sum, cnt, mine, sp = 0u;
    for (;;) {
        sum = 0u; cnt = 0u; mine = 0u;
#pragma unroll
        for (unsigned j = 0; j < 16; ++j) { const unsigned c = xb_ld(&bar[XB_XCNT(j)]); sum += c; cnt += (c > 0u) ? 1u : 0u; mine = (j == x) ? c : mine; }
        if (sum == G) break;
        __builtin_amdgcn_s_sleep(1);
        if ((++sp & 255u) == 0u) { if (xb_ld(&bar[XB_TMO])) break; if (sp > XB_SPIN_CAP) { atomicAdd(&bar[XB_TMO], 1u); break; } }
    }
    nloc = mine > 0u ? mine : 1u; nx = cnt > 0u ? cnt : 1u;
}
__device__ __forceinline__ void xcd_barrier(const XcdBarrier& b) {
    asm volatile("s_waitcnt vmcnt(0)" ::: "memory");
    __syncthreads();
    if (threadIdx.x == 0) {
        unsigned* bar = b.bar;
        __builtin_amdgcn_s_waitcnt(0);
        unsigned nloc = b.st[0], nx = b.st[1];
        if (nloc == 0u) { xcd_barrier_complete(bar, b.x, nloc, nx); b.st[0] = nloc; b.st[1] = nx; }
        const unsigned old = xb_add(&bar[XB_XSUB(b.x)], 1u);
        const unsigned gen = old / nloc;
        if (old + 1u == (gen + 1u) * nloc) {
            __builtin_amdgcn_fence(__ATOMIC_RELEASE, "agent");
            asm volatile("s_waitcnt vmcnt(0)" ::: "memory");
            const unsigned og = xb_add(&bar[XB_TOP], 1u);
            const unsigned tg = og / nx;
            if (og + 1u == (tg + 1u) * nx) xb_add(&bar[XB_TOPGEN], 1u);
            else XB_SPIN(xb_ld(&bar[XB_TOPGEN]) == tg, bar);
            __builtin_amdgcn_fence(__ATOMIC_ACQUIRE, "agent");
            xb_add(&bar[XB_XGEN(b.x)], 1u);
            asm volatile("s_waitcnt vmcnt(0)" ::: "memory");
        } else {
            XB_SPIN(xb_ld(&bar[XB_XGEN(b.x)]) == gen, bar);
            __builtin_amdgcn_fence(__ATOMIC_ACQUIRE, "agent");
            asm volatile("s_waitcnt vmcnt(0)" ::: "memory");
        }
    }
    __syncthreads();
}

namespace pg8 {
constexpr int BM = 256, BK = 64, HALF = 128, HTB = HALF * BK * 2, NXCD = 8, WGM = 8;
__device__ __forceinline__ int lds_byte(int r, int c) { const int st = (r >> 4) * 2 + (c >> 5), rr = r & 15, cc = c & 31, ob = rr * 64 + cc * 2; return st * 1024 + (ob ^ (((ob >> 9) & 1) << 5)); }
__device__ __forceinline__ void stage_rc(int b, int& R, int& C) { const int st = b / 1024, sb = b % 1024, swz = sb ^ (((sb >> 9) & 1) << 5); R = (st >> 1) * 16 + swz / 64; C = (st & 1) * 32 + (swz % 64) / 2; }
__device__ __forceinline__ int perm32(int rho) { const int n = rho >> 4, i = rho & 15; return 8 * (i >> 2) + 4 * n + (i & 3); }

struct Unit { int pm, pn, s, kb, nt, full; };
struct Gemm { const bf16_t* A; const bf16_t* Bt; int lda, ldb, K; };

struct SplitOrder {
    int nM, nN, nS, nwg, G, c, nk, sk;
    __device__ void init(int nM_, int nN_, int nS_, int G_, int c_) { nM = nM_; nN = nN_; nS = nS_; nwg = nM * nN; G = G_; c = c_; nk = 0; sk = 0; }
    __device__ void init_sk(int nM_, int nN_, int nk_, int G_, int c_) { nM = nM_; nN = nN_; nS = 2; nwg = nM * nN; G = G_; c = (G_ % 8 == 0) ? (c_ % 8) * (G_ / 8) + c_ / 8 : c_; nk = nk_; sk = 1; }
    __device__ long bnd(int cc) const { const long total = (long)nwg * nk; if (cc >= G) return total; const long base = total / G, rem = total % G; long s_ = (long)cc * base + (cc < rem ? cc : rem);
        return s_; }
    __device__ bool next(int i, Unit& u) const {
        if (sk) {
            const long s0 = bnd(c), s1 = bnd(c + 1); long s_ = s0;
            for (int k = 0; k < i; ++k) { const long te = (s_ / nk + 1) * nk; s_ = te < s1 ? te : s1; }
            if (s_ >= s1) return false;
            const int t = (int)(s_ / nk), kb = (int)(s_ % nk); const long te = (long)(t + 1) * nk; const long e = te < s1 ? te : s1; const int len = (int)(e - s_);
            u.pm = __builtin_amdgcn_readfirstlane(t / nN); u.pn = __builtin_amdgcn_readfirstlane(t % nN); u.kb = __builtin_amdgcn_readfirstlane(kb); u.nt = __builtin_amdgcn_readfirstlane(2 * len); u.s = kb == 0 ? 0 : 1; u.full = (kb == 0 && len == nk) ? 1 : 0;
            u.s = __builtin_amdgcn_readfirstlane(u.s); u.full = __builtin_amdgcn_readfirstlane(u.full); return true;
        }
        const long L = (long)i * G + c; if (L >= (long)nwg * nS) return false;
        u.s = (int)(L / nwg); int wgid = (int)(L % nwg);
        { const int q = nwg / NXCD, r = nwg % NXCD, xcd = wgid % NXCD, off = wgid / NXCD; wgid = (xcd < r ? xcd * (q + 1) : r * (q + 1) + (xcd - r) * q) + off; }
        const int nig = WGM * nN, gid = wgid / nig, fm = gid * WGM, gsz = (nM - fm) < WGM ? (nM - fm) : WGM;
        u.pm = __builtin_amdgcn_readfirstlane(fm + ((wgid % nig) % gsz)); u.pn = __builtin_amdgcn_readfirstlane((wgid % nig) / gsz); u.s = __builtin_amdgcn_readfirstlane(u.s); u.kb = 0; u.nt = 0; u.full = 0; return true;
    }
};

template <class Epi, bool FP8>
__device__ __forceinline__ void gemm_phase(LAS unsigned char* lds, const Gemm g, const SplitOrder& S, const Epi& E) {
    const int tid = TID(), wid = __builtin_amdgcn_readfirstlane(tid >> 6), lane = tid & 63, wr = wid >> 2, wc = wid & 3, fr = lane & 15, fq = lane >> 4;
    const int nt0 = g.K / BK;
    unsigned voffA[2], voffB[2];
#pragma unroll
    for (int i = 0; i < 2; ++i) { int R, C; stage_rc(tid * 16 + i * 8192, R, C); const int Rb = Epi::PERM ? ((R & ~31) + perm32(R & 31)) : R;
        voffA[i] = (unsigned)(R * g.lda + C) * 2u; voffB[i] = (unsigned)(Rb * g.ldb + C) * 2u; }
    const size_t kstep = (size_t)(BK * 2);
    const size_t hstepA = (size_t)HALF * g.lda * 2, hstepB = (size_t)HALF * g.ldb * 2;
    const size_t tstepA = 2 * hstepA, tstepB = 2 * hstepB, ksb = (size_t)g.K * 2;
    const unsigned ldsw = (unsigned)wid * 1024u;
    const int aoff = lds_byte(wr * 64 + fr, fq * 8), boff = lds_byte(wc * 32 + fr, fq * 8);
#define PG8_SA(b, h) (((b) * 2 + (h)) * HTB)
#define PG8_SB(b, h) ((4 + (b) * 2 + (h)) * HTB)
#define PG8_STAGE(bufoff, gbase, voff) do { _Pragma("unroll") for (int _i = 0; _i < 2; ++_i) \
        __builtin_amdgcn_global_load_lds((const unsigned*)((const char*)(gbase) + (voff)[_i]), (LAS unsigned*)(lds + (bufoff) + ldsw + _i * 8192), 16, 0, 0); } while (0)
#define PG8_LDA(dst, b, h) do { _Pragma("unroll") for (int m = 0; m < 4; ++m) { if (FP8) dst##8[m] = __builtin_shufflevector(*(const LAS i32x4*)(lds + PG8_SA(b, h) + aoff + m * 2048), *(const LAS i32x4*)(lds + PG8_SA(b, h) + aoff + m * 2048 + 1024), 0, 1, 2, 3, 4, 5, 6, 7); \
        else { _Pragma("unroll") for (int k = 0; k < 2; ++k) dst[m][k] = *(const LAS bf16x8*)(lds + PG8_SA(b, h) + aoff + m * 2048 + k * 1024); } } } while (0)
#define PG8_LDB(dst, b, h) do { _Pragma("unroll") for (int n = 0; n < 2; ++n) { if (FP8) dst##8[n] = __builtin_shufflevector(*(const LAS i32x4*)(lds + PG8_SB(b, h) + boff + n * 2048), *(const LAS i32x4*)(lds + PG8_SB(b, h) + boff + n * 2048 + 1024), 0, 1, 2, 3, 4, 5, 6, 7); \
        else { _Pragma("unroll") for (int k = 0; k < 2; ++k) dst[n][k] = *(const LAS bf16x8*)(lds + PG8_SB(b, h) + boff + n * 2048 + k * 1024); } } } while (0)
#define PG8_MMA(ai, bj, At, Bt) do { __builtin_amdgcn_s_setprio(1); _Pragma("unroll") for (int m = 0; m < 4; ++m) _Pragma("unroll") for (int n = 0; n < 2; ++n) { \
        if (FP8) asm volatile("v_mfma_f32_16x16x128_f8f6f4 %0, %1, %2, %0" : "+v"(acc[ai][bj][m][n]) : "v"(Bt##8[n]), "v"(At##8[m])); \
        else { _Pragma("unroll") for (int k = 0; k < 2; ++k) acc[ai][bj][m][n] = __builtin_amdgcn_mfma_f32_16x16x32_bf16(Bt[n][k], At[m][k], acc[ai][bj][m][n], 0, 0, 0); } } \
        __builtin_amdgcn_s_setprio(0); } while (0)
#define PG8_WAIT_V(n) asm volatile("s_waitcnt vmcnt(" #n ")" ::: "memory")
#define PG8_WAIT_L(n) asm volatile("s_waitcnt lgkmcnt(" #n ")" ::: "memory")
#define PG8_BAR __builtin_amdgcn_s_barrier()
#define PG8_SCHED __builtin_amdgcn_sched_barrier(0)
    Unit cur, nxt; int ui = 0;
    if (!S.next(0, cur)) return;
    f32x4 acc[2][2][4][2];
#pragma unroll
    for (int a = 0; a < 2; ++a)
#pragma unroll
        for (int b = 0; b < 2; ++b)
#pragma unroll
            for (int m = 0; m < 4; ++m)
#pragma unroll
                for (int n = 0; n < 2; ++n) acc[a][b][m][n] = (f32x4){0.f, 0.f, 0.f, 0.f};
    bf16x8 At[4][2], B0[2][2], B1[2][2]; i32x8 At8[4], B08[2], B18[2];
    const bool sk = S.sk != 0;
    const char* cA = (const char*)g.A + (size_t)cur.pm * tstepA + (sk ? (size_t)cur.kb * 256 : (size_t)cur.s * ksb); const char* cB = (const char*)g.Bt + (size_t)cur.pn * tstepB + (sk ? (size_t)cur.kb * 256 : (size_t)cur.s * ksb);
    PG8_STAGE(PG8_SB(0, 0), cB, voffB); PG8_STAGE(PG8_SA(0, 0), cA, voffA); PG8_STAGE(PG8_SB(0, 1), cB + hstepB, voffB); PG8_STAGE(PG8_SA(0, 1), cA + hstepA, voffA);
    if (wr == 1) PG8_BAR;
    PG8_WAIT_V(4); PG8_BAR;
    PG8_STAGE(PG8_SB(1, 0), cB + kstep, voffB); PG8_STAGE(PG8_SA(1, 0), cA + kstep, voffA); PG8_STAGE(PG8_SB(1, 1), cB + hstepB + kstep, voffB);
    PG8_WAIT_V(6); PG8_BAR;
    for (;;) {
        const bool has_next = S.next(ui + 1, nxt);
        const char* nA = has_next ? (const char*)g.A + (size_t)nxt.pm * tstepA + (sk ? (size_t)nxt.kb * 256 : (size_t)nxt.s * ksb) : cA; const char* nB = has_next ? (const char*)g.Bt + (size_t)nxt.pn * tstepB + (sk ? (size_t)nxt.kb * 256 : (size_t)nxt.s * ksb) : cB;
        const int nt = sk ? cur.nt : nt0;
        for (int t = 0; t < nt; t += 2) {
            const bool last = (t == nt - 2);
            const char* a1 = cA + (size_t)(t + 1) * kstep;
            const char* a2 = last ? nA : cA + (size_t)(t + 2) * kstep; const char* b2 = last ? nB : cB + (size_t)(t + 2) * kstep;
            const char* a3 = a2 + kstep; const char* b3 = b2 + kstep;
            PG8_LDB(B0, 0, 0); PG8_SCHED; PG8_LDA(At, 0, 0); PG8_STAGE(PG8_SA(1, 1), a1 + hstepA, voffA);
            PG8_WAIT_L(8); PG8_BAR; PG8_WAIT_L(0); PG8_MMA(0, 0, At, B0); PG8_BAR; PG8_SCHED;
            PG8_LDB(B1, 0, 1); PG8_STAGE(PG8_SB(0, 0), b2, voffB);
            PG8_BAR; PG8_WAIT_L(0); PG8_MMA(0, 1, At, B1); PG8_BAR;
            PG8_LDA(At, 0, 1); PG8_STAGE(PG8_SA(0, 0), a2, voffA);
            PG8_BAR; PG8_WAIT_L(0); PG8_MMA(1, 0, At, B0); PG8_BAR; PG8_SCHED;
            PG8_STAGE(PG8_SB(0, 1), b2 + hstepB, voffB);
            PG8_WAIT_V(6); PG8_BAR; PG8_MMA(1, 1, At, B1); PG8_BAR;
            PG8_LDB(B0, 1, 0); PG8_SCHED; PG8_LDA(At, 1, 0); PG8_STAGE(PG8_SA(0, 1), a2 + hstepA, voffA);
            PG8_WAIT_L(8); PG8_BAR; PG8_WAIT_L(0); PG8_MMA(0, 0, At, B0); PG8_BAR; PG8_SCHED;
            PG8_LDB(B1, 1, 1); PG8_STAGE(PG8_SB(1, 0), b3, voffB);
            PG8_BAR; PG8_WAIT_L(0); PG8_MMA(0, 1, At, B1); PG8_BAR;
            PG8_LDA(At, 1, 1); PG8_STAGE(PG8_SA(1, 0), a3, voffA);
            PG8_BAR; PG8_WAIT_L(0); PG8_MMA(1, 0, At, B0); PG8_BAR; PG8_SCHED;
            PG8_STAGE(PG8_SB(1, 1), b3 + hstepB, voffB);
            PG8_WAIT_V(6); PG8_BAR; PG8_MMA(1, 1, At, B1); PG8_BAR;
        }
        E(acc, cur, wr, wc, fr, fq);
        if (!has_next) break;
#pragma unroll
        for (int a = 0; a < 2; ++a)
#pragma unroll
            for (int b = 0; b < 2; ++b)
#pragma unroll
                for (int m = 0; m < 4; ++m)
#pragma unroll
                    for (int n = 0; n < 2; ++n) acc[a][b][m][n] = (f32x4){0.f, 0.f, 0.f, 0.f};
        cur = nxt; cA = nA; cB = nB; ++ui;
    }
    PG8_WAIT_V(0);
    if (wr == 0) PG8_BAR;
    PG8_BAR;
#undef PG8_SA
#undef PG8_SB
#undef PG8_STAGE
#undef PG8_LDA
#undef PG8_LDB
#undef PG8_MMA
#undef PG8_WAIT_V
#undef PG8_WAIT_L
#undef PG8_BAR
#undef PG8_SCHED
}
}
using pg8::Unit;

struct EpiSwiglu {
    static constexpr bool PERM = true;
    unsigned char* act;
    __device__ __forceinline__ void operator()(const f32x4 (&acc)[2][2][4][2], const Unit& u, int wr, int wc, int fr, int fq) const {
        const int row0 = u.pm * 256 + wr * 64 + fr, col0 = u.pn * 128 + wc * 32 + 8 * fq;
        constexpr float inv = 1.f / (SC_H * SC_WGU), osc = SC_ACT * inv;
#pragma unroll
        for (int ai = 0; ai < 2; ++ai)
#pragma unroll
            for (int m = 0; m < 4; ++m) {
                const f32x4 g0 = acc[ai][0][m][0] * inv, g1 = acc[ai][0][m][1] * inv, u0 = acc[ai][1][m][0] * osc, u1 = acc[ai][1][m][1] * osc;
                u32x2 w;
                w.x = pk_fp8x4(siluf(g0[0]) * u0[0], siluf(g0[1]) * u0[1], siluf(g0[2]) * u0[2], siluf(g0[3]) * u0[3]);
                w.y = pk_fp8x4(siluf(g1[0]) * u1[0], siluf(g1[1]) * u1[1], siluf(g1[2]) * u1[2], siluf(g1[3]) * u1[3]);
                *(u32x2*)(act + (size_t)(row0 + ai * 128 + m * 16) * DFF + col0) = w;
            }
    }
};
struct EpiPart {
    static constexpr bool PERM = true;
    bf16_t* part; float sc;
    __device__ __forceinline__ void operator()(const f32x4 (&acc)[2][2][4][2], const Unit& u, int wr, int wc, int fr, int fq) const {
        bf16_t* dst = part + (size_t)u.s * MP * 1024;
        const int row0 = u.pm * 256 + wr * 64 + fr, col0 = u.pn * 256 + wc * 32 + 8 * fq;
#pragma unroll
        for (int ai = 0; ai < 2; ++ai)
#pragma unroll
            for (int m = 0; m < 4; ++m) { bf16_t* rowp = dst + (size_t)(row0 + ai * 128 + m * 16) * 1024 + col0;
#pragma unroll
                for (int bj = 0; bj < 2; ++bj) { const f32x4 v0 = acc[ai][bj][m][0] * sc, v1 = acc[ai][bj][m][1] * sc;
                    u32x4 w; w.x = cvt_pk_bf16(v0[0], v0[1]); w.y = cvt_pk_bf16(v0[2], v0[3]); w.z = cvt_pk_bf16(v1[0], v1[1]); w.w = cvt_pk_bf16(v1[2], v1[3]);
                    *(u32x4*)(rowp + bj * 128) = w; if (u.full) *(u32x4*)(rowp + (size_t)MP * 1024 + bj * 128) = (u32x4){0u, 0u, 0u, 0u}; } }
    }
};
template <int KIND> struct EpiProj {
    static constexpr bool PERM = true;
    unsigned char* proj; const float* ropec; const float* ropes; const float* lbp;
    __device__ __forceinline__ void operator()(const f32x4 (&acc)[2][2][4][2], const Unit& u, int wr, int wc, int fr, int fq) const {
        int type, ld, col0; unsigned char* base; float rscale = 1.f;
        const int pn = u.pn;
        if (KIND == 0) {
            const int seg = pn >> 2; col0 = (pn & 3) * 256; ld = 1024;
            if (seg == 0) { type = 1; base = proj; }
            else if (seg == 1) { type = 4; base = proj + (size_t)MP * 2048; }
            else if (seg == 2) { type = 0; base = proj + (size_t)MP * 6144; }
            else { type = 1; base = proj + (size_t)MP * 8192; }
        } else if (KIND == 1) {
            if (pn < 4) { type = 3; base = proj; ld = 1024; col0 = pn * 256; }
            else if (pn < 8) { type = 3; base = proj + (size_t)MP * 2048; ld = 1024; col0 = (pn - 4) * 256; rscale = 0.0625f; }
            else if (pn < 16) { type = 0; base = proj + (size_t)MP * 4096; ld = 2048; col0 = (pn - 8) * 256; }
            else { type = 1; base = proj + (size_t)MP * 8192; ld = 2048; col0 = (pn - 16) * 256; }
        } else {
            if (pn < 8) { type = 1; base = proj; ld = 2048; col0 = pn * 256; }
            else if (pn < 24) { type = 0; base = proj + (size_t)MP * 4096; ld = 4096; col0 = (pn - 8) * 256; }
            else { type = 2; base = proj + (size_t)MP * 12288; ld = 256; col0 = 0; }
        }
        const int row0 = u.pm * 256 + wr * 64 + fr, cl = wc * 32 + 8 * fq;
#pragma unroll
        for (int ai = 0; ai < 2; ++ai)
#pragma unroll
            for (int m = 0; m < 4; ++m) {
                const int row = row0 + ai * 128 + m * 16;
                if (type == 2) {
                    float* rp = (float*)base + (size_t)row * ld + col0 + cl;
#pragma unroll
                    for (int bj = 0; bj < 2; ++bj)
#pragma unroll
                        for (int n = 0; n < 2; ++n) *(f32x4*)(rp + bj * 128 + 4 * n) = acc[ai][bj][m][n];
                } else if (type == 4) {
                    float* rp = (float*)base + (size_t)row * ld + col0 + cl; bf16_t* kp = (bf16_t*)(proj + (size_t)MP * 10240) + (size_t)row * ld + col0 + cl;
#pragma unroll
                    for (int bj = 0; bj < 2; ++bj) { f32x4 lfv[2], kkv[2];
#pragma unroll
                        for (int n = 0; n < 2; ++n) { const f32x4 lbq = *(const f32x4*)(lbp + col0 + cl + bj * 128 + 4 * n);
#pragma unroll
                            for (int e = 0; e < 4; ++e) { const float z = fminf(fmaxf(acc[ai][bj][m][n][e], -30.f), 30.f); const float sg = __builtin_amdgcn_rcpf(1.f + __expf(-z)); const float oml = 1.f - lbq[e];
                                lfv[n][e] = __logf(lbq[e] + oml * sg); kkv[n][e] = oml * (1.f - sg); }
                            *(f32x4*)(rp + bj * 128 + 4 * n) = lfv[n]; }
                        u32x4 w; w.x = cvt_pk_bf16(kkv[0][0], kkv[0][1]); w.y = cvt_pk_bf16(kkv[0][2], kkv[0][3]); w.z = cvt_pk_bf16(kkv[1][0], kkv[1][1]); w.w = cvt_pk_bf16(kkv[1][2], kkv[1][3]);
                        *(u32x4*)(kp + bj * 128) = w; }
                } else if (type == 3) {
                    const int pi = pos_index(row);
                    const f32x4 c0 = *(const f32x4*)(ropec + pi * 128 + cl), c1 = *(const f32x4*)(ropec + pi * 128 + cl + 4);
                    const f32x4 s0 = *(const f32x4*)(ropes + pi * 128 + cl), s1 = *(const f32x4*)(ropes + pi * 128 + cl + 4);
                    const f32x4 x10 = acc[ai][0][m][0], x11 = acc[ai][0][m][1], x20 = acc[ai][1][m][0], x21 = acc[ai][1][m][1];
                    const f32x4 a0 = (x10 * c0 - x20 * s0) * rscale, a1 = (x11 * c1 - x21 * s1) * rscale;
                    const f32x4 b0 = (x10 * s0 + x20 * c0) * rscale, b1 = (x11 * s1 + x21 * c1) * rscale;
                    bf16_t* rp = (bf16_t*)base + (size_t)row * ld + col0 + cl;
                    u32x4 w; w.x = cvt_pk_bf16(a0[0], a0[1]); w.y = cvt_pk_bf16(a0[2], a0[3]); w.z = cvt_pk_bf16(a1[0], a1[1]); w.w = cvt_pk_bf16(a1[2], a1[3]);
                    *(u32x4*)rp = w;
                    w.x = cvt_pk_bf16(b0[0], b0[1]); w.y = cvt_pk_bf16(b0[2], b0[3]); w.z = cvt_pk_bf16(b1[0], b1[1]); w.w = cvt_pk_bf16(b1[2], b1[3]);
                    *(u32x4*)(rp + 128) = w;
                } else {
                    bf16_t* rp = (bf16_t*)base + (size_t)row * ld + col0 + cl;
#pragma unroll
                    for (int bj = 0; bj < 2; ++bj) {
                        f32x4 v0 = acc[ai][bj][m][0], v1 = acc[ai][bj][m][1];
                        if (type == 1) {
#pragma unroll
                            for (int e = 0; e < 4; ++e) { v0[e] = siluf(v0[e]); v1[e] = siluf(v1[e]); }
                        }
                        u32x4 w; w.x = cvt_pk_bf16(v0[0], v0[1]); w.y = cvt_pk_bf16(v0[2], v0[3]); w.z = cvt_pk_bf16(v1[0], v1[1]); w.w = cvt_pk_bf16(v1[2], v1[3]);
                        *(u32x4*)(rp + bj * 128) = w;
                    }
                }
            }
    }
};

struct XJob { const float* src; bf16_t* dst; int K, N, grp, gstride, goff; float f8scale; };
__device__ __forceinline__ XJob xpose_job(ArgsP a_, int job) { const ArgsP a = a_;
    XJob j; j.grp = 1 << 30; j.gstride = 0; j.goff = 0; j.f8scale = 0.f;
    if (job < 16) { const int idx = job & 7; j.src = (job < 8 ? AIN(9) : AIN(10)) + (size_t)idx * 1024 * DFF; j.K = 1024; j.N = DFF;
        j.dst = (bf16_t*)(a->ws + W_GU + (size_t)idx * 5632 * 1024); j.grp = 128; j.gstride = 256; j.goff = job < 8 ? 0 : 128; j.f8scale = SC_WGU; }
    else if (job < 24) { const int idx = job - 16; j.src = AIN(11) + (size_t)idx * DFF * 1024; j.K = DFF; j.N = 1024; j.dst = (bf16_t*)(a->ws + W_D + (size_t)idx * 1024 * DFF); j.f8scale = SC_WD; }
    else if (job < 26) { const int idx = job - 24; j.src = AIN(13) + (size_t)idx * 1024 * 4096; j.K = 1024; j.N = 4096; j.dst = (bf16_t*)(a->ws + W_HGI) + (size_t)idx * 4096 * 1024; }
    else if (job < 28) { const int idx = job - 26; j.src = AIN(15) + (size_t)idx * 1024 * 1024; j.K = 1024; j.N = 1024; j.dst = (bf16_t*)(a->ws + W_HGO) + (size_t)idx * 1024 * 1024; }
    else if (job == 28) { j.src = AIN(16); j.K = 1024; j.N = 6144; j.dst = (bf16_t*)(a->ws + W_RI); }
    else if (job == 29) { j.src = AIN(18); j.K = 2048; j.N = 1024; j.dst = (bf16_t*)(a->ws + W_RO); }
    else if (job == 30) { j.src = AIN(19); j.K = 1024; j.N = 6176; j.dst = (bf16_t*)(a->ws + W_MI); }
    else { j.src = AIN(26); j.K = 2048; j.N = 1024; j.dst = (bf16_t*)(a->ws + W_MO); }
    return j;
}

template <bool F8>
__device__ __forceinline__ void xpose_run(ArgsP a_, unsigned char* smem, int c, int G) { const ArgsP a = a_;
    const int tid = TID();
    float* tile = (float*)smem;
    int base = 0;
    for (int job = 0; job < 32; ++job) {
        if ((job < 24) != F8) continue;
        const XJob j = xpose_job(a, job);
        const int nk = j.K / 64, nn = (j.N + 255) / 256, ntile = nk * nn;
        const int off = (int)(((long)c - base % G + G) % G);
        for (int t = off; t < ntile; t += G) {
            const int k0 = (t % nk) * 64, n0 = (t / nk) * 256;
            { const int n4 = (tid & 63) * 4, ks = tid >> 6;
              f32x4 v[8];
#pragma unroll
              for (int it = 0; it < 8; ++it) { const int k = ks + 8 * it; v[it] = (n0 + n4 < j.N) ? *(const f32x4*)(j.src + (size_t)(k0 + k) * j.N + n0 + n4) : (f32x4){0.f, 0.f, 0.f, 0.f}; }
#pragma unroll
              for (int it = 0; it < 8; ++it) { const int k = ks + 8 * it; float* tp = tile + k * 257 + n4; tp[0] = v[it][0]; tp[1] = v[it][1]; tp[2] = v[it][2]; tp[3] = v[it][3]; } }
            __syncthreads();
            { const int kk = tid & 7, nq = tid >> 3;
#pragma unroll
              for (int it = 0; it < 4; ++it) { const int n = nq + 64 * it; const int ng = n0 + n;
                  if (ng < j.N) { const int dr = (ng / j.grp) * j.gstride + j.goff + ng % j.grp; const float* tp = tile + (8 * kk) * 257 + n;
                      const float x0 = tp[0], x1 = tp[257], x2 = tp[2 * 257], x3 = tp[3 * 257], x4 = tp[4 * 257], x5 = tp[5 * 257], x6 = tp[6 * 257], x7 = tp[7 * 257];
                      if (F8) { const float fs = j.f8scale; *(u32x2*)((unsigned char*)j.dst + (size_t)dr * j.K + k0 + 8 * kk) = (u32x2){pk_fp8x4(x0 * fs, x1 * fs, x2 * fs, x3 * fs), pk_fp8x4(x4 * fs, x5 * fs, x6 * fs, x7 * fs)}; }
                      else *(u32x4*)(j.dst + (size_t)dr * j.K + k0 + 8 * kk) = (u32x4){cvt_pk_bf16(x0, x1), cvt_pk_bf16(x2, x3), cvt_pk_bf16(x4, x5), cvt_pk_bf16(x6, x7)}; } } }
            __syncthreads();
        }
        base += ntile;
    }
}

__device__ __forceinline__ void setup_phase(ArgsP a_, unsigned char* smem) { const ArgsP a = a_;
    const int tid = TID(), G = gridDim.x, c = BID();
    xpose_run<true>(a, smem, c, G); xpose_run<false>(a, smem, c, G);
    const size_t gt = (size_t)c * 512 + tid, gs = (size_t)G * 512;
    { unsigned* z = (unsigned*)((bf16_t*)(a->ws + W_MI) + (size_t)6176 * 1024); for (size_t i = gt; i < 224ull * 1024 / 2; i += gs) z[i] = 0u; }
    { bf16_t* HB = (bf16_t*)(a->ws + B_HB);
      for (size_t i = gt; i < (size_t)M_ * 256; i += gs) { const int row = (int)(i >> 8), c4 = (int)(i & 255) * 4; const float* src;
          if (row < RP) { const int b = row / TP, t = row % TP; src = t < 16 ? AIN(6) + (size_t)t * 1024 : AIN(0) + ((size_t)b * 2048 + t - 16) * 1024; }
          else src = AIN(1) + (size_t)(row - RP) * 1024;
          const f32x4 v = *(const f32x4*)(src + c4);
          u32x2 w; w.x = cvt_pk_bf16(v[0], v[1]); w.y = cvt_pk_bf16(v[2], v[3]); *(u32x2*)(HB + (size_t)row * 1024 + c4) = w;
          *(unsigned*)(a->ws + B_HB8 + (size_t)row * 1024 + c4) = pk_fp8x4(v[0] * SC_H, v[1] * SC_H, v[2] * SC_H, v[3] * SC_H); } }
    { float* rc = (float*)(a->ws + B_ROPE); float* rs = rc + NPOS * 128;
      for (size_t i = gt; i < (size_t)NPOS * 128; i += gs) { const int p = (int)(i >> 7), jf = (int)(i & 127); const int pos = p < TP ? p : 16384 + (p - TP);
          double f = 1.0, r = 0.930572040929699; int e = jf; while (e) { if (e & 1) f *= r; r *= r; e >>= 1; }
          double rev = (double)pos * f * 0.15915494309189535; rev -= floor(rev); const float fr_ = (float)rev;
          rc[i] = __builtin_amdgcn_cosf(fr_); rs[i] = __builtin_amdgcn_sinf(fr_); } }
    { float* LB = (float*)(a->ws + B_LB); const float* lg = AIN(12);
      for (size_t i = gt; i < 1024; i += gs) { const float l0 = lg[i], l1 = lg[1024 + i], l2 = lg[2048 + i], l3 = lg[3072 + i]; const float mx = fmaxf(fmaxf(l0, l1), fmaxf(l2, l3));
          const float e0 = __expf(l0 - mx), e1 = __expf(l1 - mx), e2 = __expf(l2 - mx), e3 = __expf(l3 - mx); LB[i] = 0.f; LB[1024 + i] = (e1 + e2 + e3) / (e0 + e1 + e2 + e3); } }
}

__device__ __forceinline__ void ln_phase(ArgsP a_, int lnidx, float cs, bool final_) { const ArgsP a = a_;
    const int lane = TID() & 63, wv = TID() >> 6; const int gw = BID() * 8 + wv, nw = gridDim.x * 8;
    bf16_t* HB = (bf16_t*)(a->ws + B_HB); const bf16_t* P0 = (const bf16_t*)(a->ws + B_PARTB); const bf16_t* P1 = P0 + (size_t)MP * 1024;
    const float* g = AIN(7) + (size_t)lnidx * 1024; const float* bb = AIN(8) + (size_t)lnidx * 1024;
    for (int row = gw; row < M_; row += nw) {
        float z[16]; float s = 0.f;
#pragma unroll
        for (int q = 0; q < 2; ++q) { const size_t o = (size_t)row * 1024 + q * 512 + lane * 8; const u32x4 h = *(const u32x4*)(HB + o), p0 = *(const u32x4*)(P0 + o), p1 = *(const u32x4*)(P1 + o);
#pragma unroll
            for (int e = 0; e < 4; ++e) { const unsigned hh = h[e], a0 = p0[e], a1 = p1[e];
                z[q * 8 + 2 * e] = __uint_as_float(hh << 16) * ALPHA + (__uint_as_float(a0 << 16) + __uint_as_float(a1 << 16)) * cs;
                z[q * 8 + 2 * e + 1] = __uint_as_float(hh & 0xffff0000u) * ALPHA + (__uint_as_float(a0 & 0xffff0000u) + __uint_as_float(a1 & 0xffff0000u)) * cs; } }
#pragma unroll
        for (int e = 0; e < 16; ++e) s += z[e];
        const float mean = wave_sum(s) * (1.f / 1024.f); float v = 0.f;
#pragma unroll
        for (int e = 0; e < 16; ++e) { const float d = z[e] - mean; v += d * d; }
        const float rstd = rsqrtf(wave_sum(v) * (1.f / 1024.f) + LN_EPS);
        float* yo = nullptr;
        if (final_) { if (row < RP) { const int b = row / TP, t = row % TP; if (t >= 16) yo = a->out + O_YP + ((size_t)b * 2048 + t - 16) * 1024; } else yo = a->out + O_YS + (size_t)(row - RP) * 1024; }
#pragma unroll
        for (int q = 0; q < 2; ++q) { const int cc = q * 512 + lane * 8; const f32x4 g0 = *(const f32x4*)(g + cc), g1 = *(const f32x4*)(g + cc + 4), b0 = *(const f32x4*)(bb + cc), b1 = *(const f32x4*)(bb + cc + 4);
            f32x4 o0, o1;
#pragma unroll
            for (int e = 0; e < 4; ++e) { o0[e] = (z[q * 8 + e] - mean) * rstd * g0[e] + b0[e]; o1[e] = (z[q * 8 + 4 + e] - mean) * rstd * g1[e] + b1[e]; }
            if (final_) { if (yo) { *(f32x4*)(yo + cc) = o0; *(f32x4*)(yo + cc + 4) = o1; } }
            else { *(u32x4*)(HB + (size_t)row * 1024 + cc) = (u32x4){cvt_pk_bf16(o0[0], o0[1]), cvt_pk_bf16(o0[2], o0[3]), cvt_pk_bf16(o1[0], o1[1]), cvt_pk_bf16(o1[2], o1[3])};
                   *(u32x2*)(a->ws + B_HB8 + (size_t)row * 1024 + cc) = (u32x2){pk_fp8x4(o0[0] * SC_H, o0[1] * SC_H, o0[2] * SC_H, o0[3] * SC_H), pk_fp8x4(o1[0] * SC_H, o1[1] * SC_H, o1[2] * SC_H, o1[3] * SC_H)}; } }
    }
}

template <int DK, int DV, bool SEPQ>
__device__ __forceinline__ void scan_core(const bf16_t* QA, const bf16_t* KB, const bf16_t* QS, const bf16_t* KT, const bf16_t* VT, const bf16_t* VT2,
                                          bf16_t* ST, bf16_t* P, const float* GI, const float* SDEC,
                                          f32x4 (&S)[DK / 128][DV / 16], f32x4 (&O)[DV / 32], int wid, int fr, int fq) {
    constexpr int LQ = DK + 8, LJ = 72, NCTW = DK / 128, NVT = DV / 16, NVTW = NVT / 2;
    const int m = wid >> 1, hw = wid & 1;
#pragma unroll
    for (int ct = 0; ct < NCTW; ++ct)
#pragma unroll
        for (int vt = 0; vt < NVT; ++vt) { const f32x4 s = S[ct][vt]; u32x2 w; w.x = cvt_pk_bf16(s[0], s[1]); w.y = cvt_pk_bf16(s[2], s[3]);
            *(u32x2*)(ST + (16 * vt + fr) * LQ + 16 * (wid * NCTW + ct) + 4 * fq) = w; }
    __syncthreads();
    {
        const float gi_i = GI[16 * m + fr];
        const int n0 = 2 * hw, n1 = 2 * hw + 1; const bool do0 = n0 <= m, do1 = n1 <= m;
        f32x4 acc0 = {0.f, 0.f, 0.f, 0.f}, acc1 = {0.f, 0.f, 0.f, 0.f};
#pragma unroll
        for (int vt = 0; vt < NVTW; ++vt) O[vt] = (f32x4){0.f, 0.f, 0.f, 0.f};
#pragma unroll
        for (int ks = 0; ks < DK / 32; ++ks) {
            const bf16x8 qf = *(const bf16x8*)(QA + (16 * m + fr) * LQ + 32 * ks + 8 * fq);
            if (do0) { const bf16x8 kf = *(const bf16x8*)(KB + (16 * n0 + fr) * LQ + 32 * ks + 8 * fq); acc0 = __builtin_amdgcn_mfma_f32_16x16x32_bf16(kf, qf, acc0, 0, 0, 0); }
            if (do1) { const bf16x8 kf = *(const bf16x8*)(KB + (16 * n1 + fr) * LQ + 32 * ks + 8 * fq); acc1 = __builtin_amdgcn_mfma_f32_16x16x32_bf16(kf, qf, acc1, 0, 0, 0); }
            bf16x8 qs = qf; if (SEPQ) qs = *(const bf16x8*)(QS + (16 * m + fr) * LQ + 32 * ks + 8 * fq);
#pragma unroll
            for (int vt = 0; vt < NVTW; ++vt) { const bf16x8 sf = *(const bf16x8*)(ST + (16 * (hw * NVTW + vt) + fr) * LQ + 32 * ks + 8 * fq); O[vt] = __builtin_amdgcn_mfma_f32_16x16x32_bf16(sf, qs, O[vt], 0, 0, 0); }
        }
#pragma unroll
        for (int nn = 0; nn < 2; ++nn) {
            const int n = 2 * hw + nn; const f32x4 acc = nn == 0 ? acc0 : acc1;
            const f32x4 gj = *(const f32x4*)(GI + 16 * n + 4 * fq); const int i = 16 * m + fr, j0 = 16 * n + 4 * fq; float p[4];
#pragma unroll
            for (int e = 0; e < 4; ++e) p[e] = (j0 + e <= i) ? acc[e] * __expf(gi_i - gj[e]) : 0.f;
            u32x2 w; w.x = cvt_pk_bf16(p[0], p[1]); w.y = cvt_pk_bf16(p[2], p[3]); *(u32x2*)(P + (16 * m + fr) * LJ + j0) = w;
        }
        const float ei = __expf(gi_i);
#pragma unroll
        for (int vt = 0; vt < NVTW; ++vt) O[vt] = O[vt] * ei;
    }
    __syncthreads();
#pragma unroll
    for (int ks = 0; ks < 2; ++ks) { const bf16x8 pf = *(const bf16x8*)(P + (16 * m + fr) * LJ + 32 * ks + 8 * fq);
#pragma unroll
        for (int vt = 0; vt < NVTW; ++vt) { const bf16x8 vf = *(const bf16x8*)(VT + (16 * (hw * NVTW + vt) + fr) * LJ + 32 * ks + 8 * fq); O[vt] = __builtin_amdgcn_mfma_f32_16x16x32_bf16(vf, pf, O[vt], 0, 0, 0); } }
#pragma unroll
    for (int ct = 0; ct < NCTW; ++ct) { const int ctg = wid * NCTW + ct; const f32x4 dec = *(const f32x4*)(SDEC + 16 * ctg + 4 * fq);
#pragma unroll
        for (int vt = 0; vt < NVT; ++vt) S[ct][vt] = S[ct][vt] * dec;
#pragma unroll
        for (int ks = 0; ks < 2; ++ks) { const bf16x8 kf = *(const bf16x8*)(KT + (16 * ctg + fr) * LJ + 32 * ks + 8 * fq);
#pragma unroll
            for (int vt = 0; vt < NVT; ++vt) { const bf16x8 vf = *(const bf16x8*)(VT2 + (16 * vt + fr) * LJ + 32 * ks + 8 * fq); S[ct][vt] = __builtin_amdgcn_mfma_f32_16x16x32_bf16(kf, vf, S[ct][vt], 0, 0, 0); } } }
}

template <int DK, int DV>
__device__ __forceinline__ void state_load(f32x4 (&S)[DK / 128][DV / 16], const float* src, int ldv, int wid, int fr, int fq, bool zero) {
#pragma unroll
    for (int ct = 0; ct < DK / 128; ++ct)
#pragma unroll
        for (int vt = 0; vt < DV / 16; ++vt) {
            if (zero) S[ct][vt] = (f32x4){0.f, 0.f, 0.f, 0.f};
            else { const float* p = src + (size_t)(16 * (wid * (DK / 128) + ct) + 4 * fq) * ldv + 16 * vt + fr; S[ct][vt] = (f32x4){p[0], p[ldv], p[2 * ldv], p[3 * ldv]}; }
        }
}
template <int DK, int DV>
__device__ __forceinline__ void state_store(const f32x4 (&S)[DK / 128][DV / 16], float* dst, int ldv, int wid, int fr, int fq) {
#pragma unroll
    for (int ct = 0; ct < DK / 128; ++ct)
#pragma unroll
        for (int vt = 0; vt < DV / 16; ++vt) { float* p = dst + (size_t)(16 * (wid * (DK / 128) + ct) + 4 * fq) * ldv + 16 * vt + fr;
            p[0] = S[ct][vt][0]; p[ldv] = S[ct][vt][1]; p[2 * ldv] = S[ct][vt][2]; p[3 * ldv] = S[ct][vt][3]; }
}

__device__ __forceinline__ void hg_block(ArgsP a_, int jl, unsigned char* smem) { const ArgsP a = a_;
    constexpr int LQ = 136, LJ = 72;
    bf16_t* QA = (bf16_t*)smem; bf16_t* KB = (bf16_t*)(smem + 17408); bf16_t* QS = (bf16_t*)(smem + 34816); bf16_t* KT = (bf16_t*)(smem + 52224); bf16_t* VT = (bf16_t*)(smem + 70656);
    bf16_t* ST = (bf16_t*)(smem + 89088); bf16_t* P = (bf16_t*)(smem + 123904); float* GI = (float*)(smem + 133120); float* SDEC = (float*)(smem + 133376);
    float* TOT = (float*)(smem + 133888);   float* RSm = (float*)(smem + 142080);
    const int tid = TID(), wid = tid >> 6, lane = tid & 63, fr = lane & 15, fq = lane >> 4;
    const int G = gridDim.x, cb = BID();
    const unsigned char* proj = a->ws + B_PROJ;
    const bf16_t* Qg = (const bf16_t*)proj; const float* LFg = (const float*)(proj + (size_t)MP * 2048); const bf16_t* Vg = (const bf16_t*)(proj + (size_t)MP * 6144); const bf16_t* Gg = (const bf16_t*)(proj + (size_t)MP * 8192);
    const bf16_t* KKg = (const bf16_t*)(proj + (size_t)MP * 10240);
    bf16_t* ON = (bf16_t*)(a->ws + B_ACT);
    const float* ng = AIN(14) + (size_t)jl * 1024;
    const int nunits = cb < 64 ? 33 : (1024 - (cb - 64) + (G - 64) - 1) / (G - 64);
    const int c4 = (tid & 31) * 4, rg = tid >> 5, m = wid >> 1, hw = wid & 1, irow = 16 * m + fr;
    f32x4 S[1][8]; f32x4 O[4];
    f32x4 lf4[4]; u32x2 kk2[4], q2[4], v2[4]; u32x2 gpre[4];
    if (tid < 64) GI[tid] = 0.f;
#define HG_DECODE(u, b_, h_, ck_, smp_, row0_, len_) do { if (cb < 64) { b_ = cb >> 3; h_ = cb & 7; ck_ = (u); smp_ = false; row0_ = b_ * TP + 64 * ck_; len_ = ck_ < 32 ? 64 : 16; } \
        else { const int it_ = (cb - 64) + (u) * (G - 64); b_ = it_ >> 3; h_ = it_ & 7; ck_ = 0; smp_ = true; row0_ = RP + 8 * b_; len_ = 8; } } while (0)
#define HG_LOAD(u) do { int b_, h_, ck_, row0_, len_; bool smp_; HG_DECODE(u, b_, h_, ck_, smp_, row0_, len_); \
        _Pragma("unroll") for (int r = 0; r < 4; ++r) { const int i = 4 * rg + r; const size_t o = (size_t)(row0_ + i) * 1024 + h_ * 128 + c4; const bool valid = i < len_; \
            const f32x4 l_ = *(const f32x4*)(LFg + o); const u32x2 k_ = *(const u32x2*)(KKg + o), q_ = *(const u32x2*)(Qg + o), v_ = *(const u32x2*)(Vg + o); const u32x2 z2 = {0u, 0u}; const f32x4 z4 = {0.f, 0.f, 0.f, 0.f}; \
            lf4[r] = valid ? l_ : z4; kk2[r] = valid ? k_ : z2; q2[r] = valid ? q_ : z2; v2[r] = valid ? v_ : z2; } \
        _Pragma("unroll") for (int vt = 0; vt < 4; ++vt) gpre[vt] = *(const u32x2*)(Gg + (size_t)(row0_ + irow) * 1024 + h_ * 128 + 16 * (hw * 4 + vt) + 4 * fq); } while (0)
    if (nunits > 0) HG_LOAD(0);
    const int ntot_ = cb < 64 ? nunits : nunits * REP_SMP;
    for (int uu = 0; uu < ntot_; ++uu) { const int u = cb < 64 ? uu : uu % nunits; const int un_ = cb < 64 ? uu + 1 : (uu + 1) % nunits;
        int b, h, ck, row0, len; bool sample; HG_DECODE(u, b, h, ck, sample, row0, len);
        const bool first = sample || ck == 0, last = sample || ck == 32;
        if (first) state_load<128, 128>(S, AIN(2) + (((size_t)jl * 128 + b) * 8 + h) * 16384, 128, wid, fr, fq, !sample);
        f32x4 cs[4];
        { f32x4 run = {0.f, 0.f, 0.f, 0.f};
#pragma unroll
          for (int r = 0; r < 4; ++r) { run = run + lf4[r]; cs[r] = run; }
          *(f32x4*)(TOT + rg * 128 + c4) = run; }
        __syncthreads();
        { f32x4 pre = {0.f, 0.f, 0.f, 0.f}, gmid = pre, glast = pre;
#pragma unroll
          for (int k = 0; k < 16; ++k) { const f32x4 t = *(const f32x4*)(TOT + k * 128 + c4); if (k < rg) pre = pre + t; if (k < 8) gmid = gmid + t; glast = glast + t; }
          f32x4 Emid, Elm;
#pragma unroll
          for (int e = 0; e < 4; ++e) { Emid[e] = __expf(gmid[e]); Elm[e] = __expf(glast[e] - gmid[e]); }
          float ktv[4][4];
#pragma unroll
          for (int r = 0; r < 4; ++r) { const int i = 4 * rg + r; const f32x4 d = pre + cs[r] - gmid;
              const f32x4 q = {__uint_as_float(q2[r].x << 16), __uint_as_float(q2[r].x & 0xffff0000u), __uint_as_float(q2[r].y << 16), __uint_as_float(q2[r].y & 0xffff0000u)};
              const f32x4 kk = {__uint_as_float(kk2[r].x << 16), __uint_as_float(kk2[r].x & 0xffff0000u), __uint_as_float(kk2[r].y << 16), __uint_as_float(kk2[r].y & 0xffff0000u)};
              f32x4 qa, qs, kb;
#pragma unroll
              for (int e = 0; e < 4; ++e) { const float eq = __expf(d[e]), ek = __expf(-d[e]); qa[e] = q[e] * eq; qs[e] = qa[e] * Emid[e]; kb[e] = kk[e] * ek; ktv[r][e] = kb[e] * Elm[e]; }
              *(u32x2*)(QA + i * LQ + c4) = (u32x2){cvt_pk_bf16(qa[0], qa[1]), cvt_pk_bf16(qa[2], qa[3])};
              *(u32x2*)(QS + i * LQ + c4) = (u32x2){cvt_pk_bf16(qs[0], qs[1]), cvt_pk_bf16(qs[2], qs[3])};
              *(u32x2*)(KB + i * LQ + c4) = (u32x2){cvt_pk_bf16(kb[0], kb[1]), cvt_pk_bf16(kb[2], kb[3])}; }
#pragma unroll
          for (int e = 0; e < 4; ++e) {
              *(u32x2*)(KT + (c4 + e) * LJ + 4 * rg) = (u32x2){cvt_pk_bf16(ktv[0][e], ktv[1][e]), cvt_pk_bf16(ktv[2][e], ktv[3][e])};
              unsigned vv[4];
#pragma unroll
              for (int r = 0; r < 4; ++r) { const unsigned w = (e < 2) ? v2[r].x : v2[r].y; vv[r] = (e & 1) ? (w >> 16) : (w & 0xffffu); }
              *(u32x2*)(VT + (c4 + e) * LJ + 4 * rg) = (u32x2){vv[0] | (vv[1] << 16), vv[2] | (vv[3] << 16)}; }
          if (rg == 0) { f32x4 sd;
#pragma unroll
              for (int e = 0; e < 4; ++e) sd[e] = __expf(glast[e]);
              *(f32x4*)(SDEC + c4) = sd; } }
        u32x2 gcur[4];
#pragma unroll
        for (int vt = 0; vt < 4; ++vt) gcur[vt] = gpre[vt];
        if (uu + 1 < ntot_) HG_LOAD(un_);
        scan_core<128, 128, true>(QA, KB, QS, KT, VT, VT, ST, P, GI, SDEC, S, O, wid, fr, fq);
        { float ss = 0.f;
#pragma unroll
          for (int vt = 0; vt < 4; ++vt) ss += (O[vt][0] * O[vt][0] + O[vt][1] * O[vt][1]) + (O[vt][2] * O[vt][2] + O[vt][3] * O[vt][3]);
          ss += __shfl_xor(ss, 16); ss += __shfl_xor(ss, 32); if (fq == 0) RSm[irow * 2 + hw] = ss; }
        __syncthreads();
        if (irow < len) { const float rstd = rsqrtf((RSm[irow * 2] + RSm[irow * 2 + 1]) * (1.f / 128.f) + LN_EPS);
#pragma unroll
            for (int vt = 0; vt < 4; ++vt) { const int v = 16 * (hw * 4 + vt) + 4 * fq; const size_t o = (size_t)(row0 + irow) * 1024 + h * 128 + v;
                const f32x4 gg = *(const f32x4*)(ng + h * 128 + v); const u32x2 gt = gcur[vt];
                const float g0 = __uint_as_float(gt.x << 16), g1 = __uint_as_float(gt.x & 0xffff0000u), g2 = __uint_as_float(gt.y << 16), g3 = __uint_as_float(gt.y & 0xffff0000u);
                u32x2 w; w.x = cvt_pk_bf16(O[vt][0] * rstd * gg[0] * g0, O[vt][1] * rstd * gg[1] * g1); w.y = cvt_pk_bf16(O[vt][2] * rstd * gg[2] * g2, O[vt][3] * rstd * gg[3] * g3);
                *(u32x2*)(ON + o) = w; } }
        if (last) { float* dst = a->out + (sample ? O_HGS : O_HGP) + (((size_t)jl * (sample ? 128 : 8) + b) * 8 + h) * 16384; state_store<128, 128>(S, dst, 128, wid, fr, fq); }
    }
#undef HG_DECODE
#undef HG_LOAD
    __syncthreads();
}

__device__ __forceinline__ void ret_block(ArgsP a_, unsigned char* smem) { const ArgsP a = a_;
    constexpr int LQ = 264, LJ = 72;
    bf16_t* QA = (bf16_t*)smem; bf16_t* KB = (bf16_t*)(smem + 33792); bf16_t* KT = (bf16_t*)(smem + 67584); bf16_t* VT = (bf16_t*)(smem + 104448);
    bf16_t* ST = (bf16_t*)(smem + 113664); bf16_t* P = (bf16_t*)(smem + 147456); float* GI = (float*)(smem + 156672); float* SDEC = (float*)(smem + 156928); float* DECJ = (float*)(smem + 157952);
    const int tid = TID(), wid = tid >> 6, lane = tid & 63, fr = lane & 15, fq = lane >> 4;
    const int G = gridDim.x, cb0 = BID();
    const int cb = (G == 256) ? ((((cb0 & 7) * 4 + (cb0 >> 6)) << 3) | ((cb0 >> 3) & 7)) : cb0;
    const unsigned char* proj = a->ws + B_PROJ;
    const bf16_t* Qg = (const bf16_t*)proj; const bf16_t* Kg = (const bf16_t*)(proj + (size_t)MP * 2048); const bf16_t* Vg = (const bf16_t*)(proj + (size_t)MP * 4096);
    bf16_t* OB = (bf16_t*)(a->ws + B_PART);
    const int np = cb < 256 ? 33 : 0;
    const int s0 = cb < 256 ? cb : cb - 256;
    const int nsmp = (4096 - (cb % 256) + G - 1) / G;
    const int nunits = np + nsmp;
    f32x4 S[2][4]; f32x4 O[2];
    u32x4 qpre[4], kpre[4]; bf16_t vpre[8];
    const int vv = tid & 63, jg = tid >> 6;
#define RT_DECODE(u, b_, h_, vs_, ck_, smp_, row0_, len_) do { if ((u) < np) { b_ = cb >> 5; h_ = (cb >> 3) & 3; vs_ = cb & 7; ck_ = (u); smp_ = false; row0_ = b_ * TP + 64 * ck_; len_ = ck_ < 32 ? 64 : 16; } \
        else { const int it_ = (cb % 256) + ((u) - np) * G; b_ = it_ >> 5; h_ = (it_ >> 3) & 3; vs_ = it_ & 7; ck_ = 0; smp_ = true; row0_ = RP + 8 * b_; len_ = 8; } } while (0)
#define RT_LOAD(u) do { int b_, h_, vs_, ck_, row0_, len_; bool smp_; RT_DECODE(u, b_, h_, vs_, ck_, smp_, row0_, len_); \
        _Pragma("unroll") for (int e = 0; e < 4; ++e) { const int idx = tid + 512 * e, i = idx >> 5, cc = idx & 31; const size_t o = (size_t)(row0_ + i) * 1024 + h_ * 256 + 8 * cc; \
            const u32x4 q_ = *(const u32x4*)(Qg + o), k_ = *(const u32x4*)(Kg + o); const bool valid = i < len_; const u32x4 zz = {0u, 0u, 0u, 0u}; qpre[e] = valid ? q_ : zz; kpre[e] = valid ? k_ : zz; } \
        _Pragma("unroll") for (int e = 0; e < 8; ++e) { const int j = 8 * jg + e; const bf16_t v_ = Vg[(size_t)(row0_ + j) * 2048 + h_ * 512 + vs_ * 64 + vv]; vpre[e] = (j < len_) ? v_ : (bf16_t)0; } } while (0)
    (void)s0;
    if (nunits > 0) RT_LOAD(0);
    const int ntot_ = np + nsmp * REP_SMP;
    for (int uu = 0; uu < ntot_; ++uu) { const int u = uu < np ? uu : np + (uu - np) % nsmp; const int un_ = uu + 1 < np ? uu + 1 : np + (uu + 1 - np) % nsmp;
        int b, h, vs, ck, row0, len; bool sample; RT_DECODE(u, b, h, vs, ck, sample, row0, len);
        const bool first = sample || ck == 0, last = sample || ck == 32;
        const float lgam = __logf(1.f - exp2f(-5.f - (float)h));
        if (first) state_load<256, 64>(S, AIN(3) + (((size_t)b * 4 + h) * 256) * 512 + vs * 64, 512, wid, fr, fq, !sample);
#pragma unroll
        for (int e = 0; e < 4; ++e) { const int idx = tid + 512 * e, i = idx >> 5, cc = idx & 31; *(u32x4*)(QA + i * LQ + 8 * cc) = qpre[e]; *(u32x4*)(KB + i * LQ + 8 * cc) = kpre[e]; }
        *(u32x4*)(VT + vv * LJ + 8 * jg) = (u32x4){(unsigned)vpre[0] | ((unsigned)vpre[1] << 16), (unsigned)vpre[2] | ((unsigned)vpre[3] << 16), (unsigned)vpre[4] | ((unsigned)vpre[5] << 16), (unsigned)vpre[6] | ((unsigned)vpre[7] << 16)};
        if (tid < 64) { GI[tid] = (float)((tid + 1 < len) ? tid + 1 : len) * lgam; DECJ[tid] = tid < len ? __expf((float)(len - 1 - tid) * lgam) : 0.f; }
        if (tid < 256) SDEC[tid] = __expf((float)len * lgam);
        __syncthreads();
        if (uu + 1 < ntot_) RT_LOAD(un_);
        { const int cp = tid & 127, jq = tid >> 7;
          float dj[16];
#pragma unroll
          for (int q4 = 0; q4 < 4; ++q4) { const f32x4 t = *(const f32x4*)(DECJ + 16 * jq + 4 * q4); dj[4 * q4] = t[0]; dj[4 * q4 + 1] = t[1]; dj[4 * q4 + 2] = t[2]; dj[4 * q4 + 3] = t[3]; }
          unsigned lo[8], hi[8];
#pragma unroll
          for (int e = 0; e < 8; ++e) { const int j = 16 * jq + 2 * e; const unsigned w0 = *(const unsigned*)(KB + j * LQ + 2 * cp), w1 = *(const unsigned*)(KB + (j + 1) * LQ + 2 * cp);
              lo[e] = cvt_pk_bf16(__uint_as_float(w0 << 16) * dj[2 * e], __uint_as_float(w1 << 16) * dj[2 * e + 1]);
              hi[e] = cvt_pk_bf16(__uint_as_float(w0 & 0xffff0000u) * dj[2 * e], __uint_as_float(w1 & 0xffff0000u) * dj[2 * e + 1]); }
          *(u32x4*)(KT + (2 * cp) * LJ + 16 * jq) = (u32x4){lo[0], lo[1], lo[2], lo[3]}; *(u32x4*)(KT + (2 * cp) * LJ + 16 * jq + 8) = (u32x4){lo[4], lo[5], lo[6], lo[7]};
          *(u32x4*)(KT + (2 * cp + 1) * LJ + 16 * jq) = (u32x4){hi[0], hi[1], hi[2], hi[3]}; *(u32x4*)(KT + (2 * cp + 1) * LJ + 16 * jq + 8) = (u32x4){hi[4], hi[5], hi[6], hi[7]}; }
        scan_core<256, 64, false>(QA, KB, QA, KT, VT, VT, ST, P, GI, SDEC, S, O, wid, fr, fq);
        const int m = wid >> 1, hw = wid & 1, i = 16 * m + fr;
        if (i < len) {
#pragma unroll
            for (int vt = 0; vt < 2; ++vt) *(u32x2*)(OB + (size_t)(row0 + i) * 2048 + h * 512 + vs * 64 + 16 * (hw * 2 + vt) + 4 * fq) = (u32x2){cvt_pk_bf16(O[vt][0], O[vt][1]), cvt_pk_bf16(O[vt][2], O[vt][3])}; }
        if (last) { float* dst = a->out + (sample ? O_RTS : O_RTP) + (((size_t)b * 4 + h) * 256) * 512 + vs * 64; state_store<256, 64>(S, dst, 512, wid, fr, fq); }
        __syncthreads();
    }
#undef RT_DECODE
#undef RT_LOAD
}

__device__ __forceinline__ void mamba_block(ArgsP a_, unsigned char* smem) { const ArgsP a = a_;
    constexpr int LQ = 136, LJ = 72;
    bf16_t* QA = (bf16_t*)smem; bf16_t* KB = (bf16_t*)(smem + 17408); bf16_t* KT = (bf16_t*)(smem + 34816); bf16_t* VT = (bf16_t*)(smem + 53248); bf16_t* VT2 = (bf16_t*)(smem + 62464);
    bf16_t* ST = (bf16_t*)(smem + 71680); bf16_t* P = (bf16_t*)(smem + 89088); float* GI = (float*)(smem + 98304); float* SDEC = (float*)(smem + 98560); float* DTV = (float*)(smem + 99072); float* W2 = (float*)(smem + 99584);
    const int tid = TID(), wid = tid >> 6, lane = tid & 63, fr = lane & 15, fq = lane >> 4;
    const int G = gridDim.x, cb0 = BID();
    const int cb = (G == 256) ? ((((cb0 & 7) * 8 + (cb0 >> 5)) << 2) | ((cb0 >> 3) & 3)) : cb0;
    const unsigned char* proj = a->ws + B_PROJ;
    const bf16_t* ZG = (const bf16_t*)proj; const float* DT = (const float*)(proj + (size_t)MP * 12288); const bf16_t* XC = (const bf16_t*)(proj + (size_t)MP * 13312);
    bf16_t* YB = (bf16_t*)(a->ws + B_PART);
    const int np = cb < 256 ? 33 : 0; const int nsmp = (4096 - (cb % 256) + G - 1) / G; const int nunits = np + nsmp;
    f32x4 S[1][4]; f32x4 O[2];
    u32x4 bpre[2], cpre[2]; bf16_t xpre[8]; float dtpre = 0.f;
    const int vv = tid & 63, jg = tid >> 6;
#define MB_DECODE(u, b_, hd_, ck_, smp_, row0_, len_) do { if ((u) < np) { b_ = cb >> 5; hd_ = cb & 31; ck_ = (u); smp_ = false; row0_ = b_ * TP + 64 * ck_; len_ = ck_ < 32 ? 64 : 16; } \
        else { const int it_ = (cb % 256) + ((u) - np) * G; b_ = it_ >> 5; hd_ = it_ & 31; ck_ = 0; smp_ = true; row0_ = RP + 8 * b_; len_ = 8; } } while (0)
#define MB_LOAD(u) do { int b_, hd_, ck_, row0_, len_; bool smp_; MB_DECODE(u, b_, hd_, ck_, smp_, row0_, len_); const int grp_ = hd_ >> 2; \
        _Pragma("unroll") for (int e = 0; e < 2; ++e) { const int idx = tid + 512 * e, i = idx >> 4, cc = idx & 15; const size_t o = (size_t)(row0_ + i) * 4096 + 2048 + 128 * grp_ + 8 * cc; \
            const u32x4 b4 = *(const u32x4*)(XC + o), c4 = *(const u32x4*)(XC + o + 1024); const bool valid = i < len_; const u32x4 zz = {0u, 0u, 0u, 0u}; bpre[e] = valid ? b4 : zz; cpre[e] = valid ? c4 : zz; } \
        _Pragma("unroll") for (int e = 0; e < 8; ++e) { const int j = 8 * jg + e; const bf16_t x_ = XC[(size_t)(row0_ + j) * 4096 + hd_ * 64 + vv]; xpre[e] = (j < len_) ? x_ : (bf16_t)0; } \
        if (tid < 64) dtpre = DT[(size_t)(row0_ + tid) * 256 + hd_]; } while (0)
    if (nunits > 0) MB_LOAD(0);
    const int ntot_ = np + nsmp * REP_SMP;
    for (int uu = 0; uu < ntot_; ++uu) { const int u = uu < np ? uu : np + (uu - np) % nsmp; const int un_ = uu + 1 < np ? uu + 1 : np + (uu + 1 - np) % nsmp;
        int b, hd, ck, row0, len; bool sample; MB_DECODE(u, b, hd, ck, sample, row0, len);
        const bool first = sample || ck == 0, last = sample || ck == 32;
        if (first) state_load<128, 64>(S, AIN(4) + (((size_t)b * 32 + hd) * 128) * 64, 64, wid, fr, fq, !sample);
#pragma unroll
        for (int e = 0; e < 2; ++e) { const int idx = tid + 512 * e, i = idx >> 4, cc = idx & 15; *(u32x4*)(KB + i * LQ + 8 * cc) = bpre[e]; *(u32x4*)(QA + i * LQ + 8 * cc) = cpre[e]; }
        if (tid < 64) { const int j = tid; const bool valid = j < len; const float dtr = dtpre + AIN(22)[hd];
            const float dt = valid ? (dtr > 20.f ? dtr : log1pf(__expf(dtr))) : 0.f; float x = -dt * __expf(AIN(23)[hd]);
#pragma unroll
            for (int off = 1; off < 64; off <<= 1) { const float t = __shfl_up(x, off); if (lane >= off) x += t; }
            const float glast = __shfl(x, 63); GI[j] = x; DTV[j] = dt; W2[j] = dt * __expf(glast - x); const float ed = __expf(glast); SDEC[2 * j] = ed; SDEC[2 * j + 1] = ed; }
        __syncthreads();
        { unsigned w1[4], w2[4];
#pragma unroll
          for (int e = 0; e < 4; ++e) { const int j = 8 * jg + 2 * e; const float x0 = bf2f(xpre[2 * e]), x1 = bf2f(xpre[2 * e + 1]);
              w1[e] = cvt_pk_bf16(x0 * DTV[j], x1 * DTV[j + 1]); w2[e] = cvt_pk_bf16(x0 * W2[j], x1 * W2[j + 1]); }
          *(u32x4*)(VT + vv * LJ + 8 * jg) = (u32x4){w1[0], w1[1], w1[2], w1[3]}; *(u32x4*)(VT2 + vv * LJ + 8 * jg) = (u32x4){w2[0], w2[1], w2[2], w2[3]}; }
        { const int cp = tid & 63, jq = tid >> 6;
          unsigned lo[4], hi[4];
#pragma unroll
          for (int e = 0; e < 4; ++e) { const int j = 8 * jq + 2 * e; const unsigned w0 = *(const unsigned*)(KB + j * LQ + 2 * cp), w1 = *(const unsigned*)(KB + (j + 1) * LQ + 2 * cp);
              lo[e] = (w0 & 0xffffu) | (w1 << 16); hi[e] = (w0 >> 16) | (w1 & 0xffff0000u); }
          *(u32x4*)(KT + (2 * cp) * LJ + 8 * jq) = (u32x4){lo[0], lo[1], lo[2], lo[3]}; *(u32x4*)(KT + (2 * cp + 1) * LJ + 8 * jq) = (u32x4){hi[0], hi[1], hi[2], hi[3]}; }
        if (uu + 1 < ntot_) MB_LOAD(un_);
        scan_core<128, 64, false>(QA, KB, QA, KT, VT, VT2, ST, P, GI, SDEC, S, O, wid, fr, fq);
        const int m = wid >> 1, hw = wid & 1, i = 16 * m + fr;
        if (i < len) { const float Dh = AIN(24)[hd];
#pragma unroll
            for (int vt = 0; vt < 2; ++vt) { const int v = 16 * (hw * 2 + vt) + 4 * fq; const size_t o = (size_t)(row0 + i) * 2048 + hd * 64 + v;
                const u32x2 xt = *(const u32x2*)(XC + (size_t)(row0 + i) * 4096 + hd * 64 + v); const u32x2 zt = *(const u32x2*)(ZG + o);
                const f32x4 xs = {__uint_as_float(xt.x << 16), __uint_as_float(xt.x & 0xffff0000u), __uint_as_float(xt.y << 16), __uint_as_float(xt.y & 0xffff0000u)};
                const f32x4 zg = {__uint_as_float(zt.x << 16), __uint_as_float(zt.x & 0xffff0000u), __uint_as_float(zt.y << 16), __uint_as_float(zt.y & 0xffff0000u)};
                const f32x4 y = (O[vt] + xs * Dh) * zg; *(u32x2*)(YB + o) = (u32x2){cvt_pk_bf16(y[0], y[1]), cvt_pk_bf16(y[2], y[3])}; } }
        if (last) { float* dst = a->out + (sample ? O_SSS : O_SSP) + (((size_t)b * 32 + hd) * 128) * 64; state_store<128, 64>(S, dst, 64, wid, fr, fq); }
        __syncthreads();
    }
#undef MB_DECODE
#undef MB_LOAD
}

__device__ __forceinline__ void scan_phase(ArgsP a_, int kind, int jl, unsigned char* smem) { const ArgsP a = a_;
    if (kind == 0) { hg_block(a, jl, smem);
    }
    else if (kind == 1) ret_block(a, smem); else mamba_block(a, smem);
}

__device__ __forceinline__ void conv_phase(ArgsP a_) { const ArgsP a = a_;
    const unsigned char* proj = a->ws + B_PROJ; const bf16_t* XBC = (const bf16_t*)(proj + (size_t)MP * 4096); bf16_t* XC = (bf16_t*)(proj + (size_t)MP * 13312);
    const float* cw = AIN(20); const float* cbias = AIN(21); const float* c0 = AIN(5);
    const size_t gt = (size_t)BID() * 512 + TID(), gs = (size_t)gridDim.x * 512;
    for (size_t t = gt; t < (size_t)(8 * 129 + 128) * 512; t += gs) {
        const int cg8 = (int)(t & 511), seg = (int)(t >> 9); const int col = cg8 * 8;
        int row0, nrow, hist; const float* st = nullptr;
        if (seg < 8 * 129) { const int b = seg / 129, s = seg % 129; row0 = b * TP + 16 * s; nrow = 16; hist = s == 0 ? 0 : 1; }
        else { const int b = seg - 8 * 129; row0 = RP + 8 * b; nrow = 8; hist = 2; st = c0 + (size_t)b * 3 * 4096 + col; }
        float w[4][8], bs[8];
#pragma unroll
        for (int k = 0; k < 4; ++k) { const f32x4 x0 = *(const f32x4*)(cw + k * 4096 + col), x1 = *(const f32x4*)(cw + k * 4096 + col + 4);
#pragma unroll
            for (int e = 0; e < 4; ++e) { w[k][e] = x0[e]; w[k][4 + e] = x1[e]; } }
        { const f32x4 x0 = *(const f32x4*)(cbias + col), x1 = *(const f32x4*)(cbias + col + 4);
#pragma unroll
          for (int e = 0; e < 4; ++e) { bs[e] = x0[e]; bs[4 + e] = x1[e]; } }
        float r[3][8];
#pragma unroll
        for (int k = 0; k < 3; ++k) {
            if (hist == 0) {
#pragma unroll
                for (int e = 0; e < 8; ++e) r[k][e] = 0.f;
            } else if (hist == 1) { const u32x4 x = *(const u32x4*)(XBC + (size_t)(row0 - 3 + k) * 4096 + col);
                r[k][0] = __uint_as_float(x.x << 16); r[k][1] = __uint_as_float(x.x & 0xffff0000u); r[k][2] = __uint_as_float(x.y << 16); r[k][3] = __uint_as_float(x.y & 0xffff0000u);
                r[k][4] = __uint_as_float(x.z << 16); r[k][5] = __uint_as_float(x.z & 0xffff0000u); r[k][6] = __uint_as_float(x.w << 16); r[k][7] = __uint_as_float(x.w & 0xffff0000u);
            } else { const f32x4 x0 = *(const f32x4*)(st + k * 4096), x1 = *(const f32x4*)(st + k * 4096 + 4);
#pragma unroll
                for (int e = 0; e < 4; ++e) { r[k][e] = x0[e]; r[k][4 + e] = x1[e]; } }
        }
        for (int j = 0; j < nrow; ++j) {
            const u32x4 x = *(const u32x4*)(XBC + (size_t)(row0 + j) * 4096 + col); float cur[8];
            cur[0] = __uint_as_float(x.x << 16); cur[1] = __uint_as_float(x.x & 0xffff0000u); cur[2] = __uint_as_float(x.y << 16); cur[3] = __uint_as_float(x.y & 0xffff0000u);
            cur[4] = __uint_as_float(x.z << 16); cur[5] = __uint_as_float(x.z & 0xffff0000u); cur[6] = __uint_as_float(x.w << 16); cur[7] = __uint_as_float(x.w & 0xffff0000u);
            float y[8];
#pragma unroll
            for (int e = 0; e < 8; ++e) { y[e] = siluf(bs[e] + w[0][e] * r[0][e] + w[1][e] * r[1][e] + w[2][e] * r[2][e] + w[3][e] * cur[e]); r[0][e] = r[1][e]; r[1][e] = r[2][e]; r[2][e] = cur[e]; }
            *(u32x4*)(XC + (size_t)(row0 + j) * 4096 + col) = (u32x4){cvt_pk_bf16(y[0], y[1]), cvt_pk_bf16(y[2], y[3]), cvt_pk_bf16(y[4], y[5]), cvt_pk_bf16(y[6], y[7])};
        }
    }
}

__device__ __forceinline__ void norm_phase(ArgsP a_, int kind) { const ArgsP a = a_;
    const int lane = TID() & 63, wv = TID() >> 6; const int gw = BID() * 8 + wv, nw = gridDim.x * 8;
    const bf16_t* OB = (const bf16_t*)(a->ws + B_PART); bf16_t* ON = (bf16_t*)(a->ws + B_ACT); const unsigned char* proj = a->ws + B_PROJ;
    const float* ngp = (kind == 1 ? AIN(17) : AIN(25)) + lane * 32;
    f32x4 gq[8];
#pragma unroll
    for (int q = 0; q < 8; ++q) gq[q] = *(const f32x4*)(ngp + 4 * q);
    const bf16_t* Gg = (const bf16_t*)(proj + (size_t)MP * 8192);
    for (int row = gw; row < M_; row += nw) {
        const size_t o = (size_t)row * 2048 + lane * 32;
        u32x4 xr[4], gr[4];
#pragma unroll
        for (int q = 0; q < 4; ++q) xr[q] = *(const u32x4*)(OB + o + 8 * q);
        if (kind == 1) {
#pragma unroll
            for (int q = 0; q < 4; ++q) gr[q] = *(const u32x4*)(Gg + o + 8 * q);
        }
        float x[32];
#pragma unroll
        for (int q = 0; q < 4; ++q)
#pragma unroll
            for (int e = 0; e < 4; ++e) { x[8 * q + 2 * e] = __uint_as_float(xr[q][e] << 16); x[8 * q + 2 * e + 1] = __uint_as_float(xr[q][e] & 0xffff0000u); }
        float mean = 0.f, rstd;
        if (kind == 1) {
            float s1 = 0.f;
#pragma unroll
            for (int e = 0; e < 32; ++e) s1 += x[e];
            s1 += __shfl_xor(s1, 1); s1 += __shfl_xor(s1, 2); s1 += __shfl_xor(s1, 4); s1 += __shfl_xor(s1, 8);
            mean = s1 * (1.f / 512.f);
            float s2 = 0.f;
#pragma unroll
            for (int e = 0; e < 32; ++e) { const float d = x[e] - mean; s2 += d * d; }
            s2 += __shfl_xor(s2, 1); s2 += __shfl_xor(s2, 2); s2 += __shfl_xor(s2, 4); s2 += __shfl_xor(s2, 8);
            rstd = rsqrtf(s2 * (1.f / 512.f) + LN_EPS);
        } else {
            float s2 = 0.f;
#pragma unroll
            for (int e = 0; e < 32; ++e) s2 += x[e] * x[e];
            s2 += __shfl_xor(s2, 1); s2 += __shfl_xor(s2, 2); s2 += __shfl_xor(s2, 4);
            rstd = rsqrtf(s2 * (1.f / 256.f) + LN_EPS);
        }
#pragma unroll
        for (int q = 0; q < 4; ++q) {
            float y[8];
#pragma unroll
            for (int e = 0; e < 8; ++e) y[e] = (x[8 * q + e] - mean) * rstd * gq[2 * q + (e >> 2)][e & 3];
            if (kind == 1) {
#pragma unroll
                for (int e = 0; e < 4; ++e) { y[2 * e] *= __uint_as_float(gr[q][e] << 16); y[2 * e + 1] *= __uint_as_float(gr[q][e] & 0xffff0000u); }
            }
            *(u32x4*)(ON + o + 8 * q) = (u32x4){cvt_pk_bf16(y[0], y[1]), cvt_pk_bf16(y[2], y[3]), cvt_pk_bf16(y[4], y[5]), cvt_pk_bf16(y[6], y[7])};
        }
    }
    if (kind != 1) {
        const bf16_t* XBC = (const bf16_t*)(proj + (size_t)MP * 4096);
        const size_t gt = (size_t)BID() * 512 + TID(), gs = (size_t)gridDim.x * 512;
        for (size_t i = gt; i < (size_t)(8 + 128) * 3 * 4096; i += gs) { const int col = (int)(i & 4095); const int rk = (int)(i >> 12); const int bb = rk / 3, k = rk % 3;
            if (bb < 8) a->out[O_CVP + i] = bf2f(XBC[(size_t)(bb * TP + TP - 3 + k) * 4096 + col]);
            else { const int sb = bb - 8; a->out[O_CVS + ((size_t)sb * 3 + k) * 4096 + col] = bf2f(XBC[(size_t)(RP + sb * 8 + 5 + k) * 4096 + col]); } }
    }
}

__device__ __forceinline__ void decode_phase(int p, int& L, int& sub) {
    if (p == 0) { L = -1; sub = -1; return; }
    p -= 1;
    for (int l = 0; l < 4; ++l) { const int kind = l % 3; const int n = kind == 0 ? 10 : (kind == 1 ? 11 : 12);
        if (p < n) { L = l;
            if (kind == 0) sub = p < 5 ? p : p + 1;
            else if (kind == 1) sub = p;
            else sub = p < 4 ? p : (p == 4 ? 11 : p - 1);
            return; }
        p -= n; }
    L = -2; sub = -2;
}
constexpr int NPHASE = 1 + 10 + 11 + 12 + 10;
#ifndef REP_SETUP
#define REP_SETUP 1
#endif
#ifndef REP_SCAN
#define REP_SCAN 1
#endif

__global__ void __launch_bounds__(512, 2) fwd_megakernel(Args a_unused) {
    extern __shared__ __attribute__((aligned(16))) unsigned char smem[];
    cg::grid_group grid = cg::this_grid();
    const ArgsP ka = (ArgsP)__builtin_amdgcn_kernarg_segment_ptr();
    const int ph_lo = ka->ph_lo, ph_hi = ka->ph_hi;
    volatile LAS unsigned* xst = (volatile LAS unsigned*)(smem + LDS_BYTES - 16);
    if (threadIdx.x == 0) { xst[0] = 0u; xst[1] = 0u; }
    __syncthreads();
    const XcdBarrier xb = xcd_barrier_post((unsigned*)(ka->ws + B_BAR), xst);
    for (int p = ph_lo; p < ph_hi; ++p) {
        int L, sub; decode_phase(p, L, sub);
        const ArgsP a = launder(ka);
        const int G = gridDim.x, c = BID();
        if (L == -1) { for (int rep = 0; rep < REP_SETUP; ++rep) { setup_phase(launder(ka), smem); __syncthreads(); } }
        else if (L >= 0) {
            const int kind = L % 3, jl = L / 3;
            unsigned char* ws = a->ws;
            pg8::Gemm g; pg8::SplitOrder S;
            switch (sub) {
            case 0: case 8: { const int f = sub == 0 ? 0 : 1; g.A = (const bf16_t*)(ws + B_HB8); g.lda = 512; g.Bt = (const bf16_t*)(ws + W_GU + (size_t)(2 * L + f) * 5632 * 1024); g.ldb = 512; g.K = 512;
                S.init(69, 22, 1, G, c); EpiSwiglu E{ws + B_ACT}; for (int rep = 0; rep < REP_GEMM; ++rep) { pg8::gemm_phase<EpiSwiglu, true>((LAS unsigned char*)smem, g, S, E); } } break;
            case 1: case 9: { const int f = sub == 1 ? 0 : 1; g.A = (const bf16_t*)(ws + B_ACT); g.lda = DFF / 2; g.ldb = DFF / 2; g.K = DFF / 2; g.Bt = (const bf16_t*)(ws + W_D + (size_t)(2 * L + f) * 1024 * DFF);
                S.init_sk(69, 4, 11, G, c); EpiPart E{(bf16_t*)(ws + B_PARTB), 1.f / (SC_ACT * SC_WD)}; for (int rep = 0; rep < REP_GEMM; ++rep) { pg8::gemm_phase<EpiPart, true>((LAS unsigned char*)smem, g, S, E); } } break;
            case 6: { g.A = (const bf16_t*)(ws + B_ACT);
                if (kind == 0) { g.lda = 1024; g.ldb = 1024; g.K = 512; g.Bt = (const bf16_t*)(ws + W_HGO) + (size_t)jl * 1024 * 1024; }
                else { g.lda = 2048; g.ldb = 2048; g.K = 1024; g.Bt = (const bf16_t*)(ws + (kind == 1 ? W_RO : W_MO)); }
                S.init_sk(69, 4, (kind == 0 ? 8 : 16), G, c); EpiPart E{(bf16_t*)(ws + B_PARTB), 1.f}; for (int rep = 0; rep < REP_GEMM; ++rep) { pg8::gemm_phase<EpiPart, false>((LAS unsigned char*)smem, g, S, E); } } break;
            case 2: ln_phase(a, L * 3 + 0, 0.5f, false); break;
            case 7: ln_phase(a, L * 3 + 1, 1.0f, false); break;
            case 10: ln_phase(a, L * 3 + 2, 0.5f, L == 3); break;
            case 3: { g.A = (const bf16_t*)(ws + B_HB); g.lda = 1024; g.ldb = 1024; g.K = 1024;
                const float* rc = (const float*)(ws + B_ROPE);
                if (kind == 0) { g.Bt = (const bf16_t*)(ws + W_HGI) + (size_t)jl * 4096 * 1024; S.init(69, 16, 1, G, c); EpiProj<0> E{ws + B_PROJ, rc, rc + NPOS * 128, (const float*)(ws + B_LB) + jl * 1024}; for (int rep = 0; rep < REP_GEMM; ++rep) { pg8::gemm_phase<decltype(E), false>((LAS unsigned char*)smem, g, S, E); } }
                else if (kind == 1) { g.Bt = (const bf16_t*)(ws + W_RI); S.init(69, 24, 1, G, c); EpiProj<1> E{ws + B_PROJ, rc, rc + NPOS * 128, nullptr}; for (int rep = 0; rep < REP_GEMM; ++rep) { pg8::gemm_phase<decltype(E), false>((LAS unsigned char*)smem, g, S, E); } }
                else { g.Bt = (const bf16_t*)(ws + W_MI); S.init(69, 25, 1, G, c); EpiProj<2> E{ws + B_PROJ, rc, rc + NPOS * 128, nullptr}; for (int rep = 0; rep < REP_GEMM; ++rep) { pg8::gemm_phase<decltype(E), false>((LAS unsigned char*)smem, g, S, E); } } } break;
#ifndef NO_SCAN
            case 4: for (int rep = 0; rep < REP_SCAN; ++rep) { scan_phase(launder(ka), kind, jl, smem); __syncthreads(); } break;
#endif
            case 5: norm_phase(a, kind); break;
            case 11: conv_phase(a); break;
            default: break;
            }
        }
        if (p + 1 < ph_hi) { if (p == ph_lo) grid.sync(); else xcd_barrier(xb); }
    }
}

extern "C" void kernel_launch(void* const* d_in, const int* in_sizes, int n_in, void* d_out, int out_size, void* d_ws, size_t ws_size, hipStream_t stream) {
    static int grid_blocks = 0;
    if (!grid_blocks) {
        int dev = 0, cus = 0, per_cu = 0;
        (void)hipGetDevice(&dev);
        (void)hipDeviceGetAttribute(&cus, hipDeviceAttributeMultiprocessorCount, dev);
        if (hipFuncSetAttribute((const void*)fwd_megakernel, hipFuncAttributeMaxDynamicSharedMemorySize, LDS_BYTES) != hipSuccess) fprintf(stderr, "hipFuncSetAttribute failed\n");
        if (hipOccupancyMaxActiveBlocksPerMultiprocessor(&per_cu, (const void*)fwd_megakernel, 512, LDS_BYTES) != hipSuccess || per_cu < 1) { fprintf(stderr, "occupancy query says %d\n", per_cu); per_cu = 1; }
        (void)hipGetLastError();
        grid_blocks = cus * 1;
        if (ws_size < WS_END) fprintf(stderr, "workspace too small: %zu < %zu\n", ws_size, (size_t)WS_END);
    }
    Args a{};
    for (int i = 0; i < 27; ++i) a.in[i] = (const float*)d_in[i];
    a.out = (float*)d_out; a.ws = (unsigned char*)d_ws; a.ph_lo = 0; a.ph_hi = NPHASE;
    (void)hipMemsetAsync((unsigned char*)d_ws + B_BAR, 0, 3456 * 4, stream);
    void* args[] = {&a};
    hipError_t e = hipLaunchCooperativeKernel((const void*)fwd_megakernel, dim3(grid_blocks), dim3(512), args, LDS_BYTES, stream);
    if (e != hipSuccess) fprintf(stderr, "cooperative launch failed: %s (grid %d)\n", hipGetErrorString(e), grid_blocks);
}
```
